# Optimizing an MI355X kernel written in HIP

```python
import jax, jax.numpy as jnp
from jax import lax
import numpy as np

D_MODEL = 2048
BATCH = 4
SEQ = 4096
DEPTH = 4

N_MIXERS = 3
N_RWKV = (DEPTH + 2) // 3
N_SWA = (DEPTH + 1) // 3
N_CONV = DEPTH // 3
RMS_EPS = 1e-6

RWKV_HEAD = 64
RWKV_HEADS = D_MODEL // RWKV_HEAD
DECAY_LORA = 96
AAA_LORA = 96
MV_LORA = 64
GATE_LORA = 256
GN_EPS = 64e-5
N_MIX_COEF = 6

ATT_HEAD = 64
N_Q_HEADS = D_MODEL // ATT_HEAD
N_KV_HEADS = max(4, N_Q_HEADS // 8)
Q_PER_KV = N_Q_HEADS // N_KV_HEADS
WINDOW = 128
BLOCK = 128

CONV_W = 3

D_FF = 4 * D_MODEL

kernel_name = "hybrid_rwkv7_swa_sink_shortconv_trunk"


def rms_norm(x, g):
    xf = x.astype(jnp.float32)
    y = xf * lax.rsqrt(jnp.mean(xf * xf, axis=-1, keepdims=True) + RMS_EPS)
    return (y * g.astype(jnp.float32)).astype(x.dtype)


def token_shift(x):
    return jnp.pad(x, ((0, 0), (1, 0), (0, 0)))[:, :-1]


def rwkv7_scan(r, w, k, v, a, b):
    bsz, _, h, n = r.shape

    def step(S, inp):
        r_t, w_t, k_t, v_t, a_t, b_t = inp
        sa = jnp.einsum('bhij,bhj->bhi', S, a_t)
        S = S * w_t[:, :, None, :] + sa[..., None] * b_t[:, :, None, :] + v_t[..., None] * k_t[:, :, None, :]
        return S, jnp.einsum('bhij,bhj->bhi', S, r_t)

    S0 = jnp.zeros((bsz, h, n, n), jnp.float32)
    seq = tuple(jnp.moveaxis(t, 1, 0) for t in (r, w, k, v, a, b))
    _, y = lax.scan(step, S0, seq)
    return jnp.moveaxis(y, 0, 1)


def rwkv7_time_mix(x, v_first, mu, w_rkv, w_o, w0, w1, w2, a0, a1, a2, g1, g2,
                   k_k, k_a, r_k, lnx_w, lnx_b, vres):
    B, T, D = x.shape
    H, N = RWKV_HEADS, RWKV_HEAD
    f32 = jnp.float32
    xx = token_shift(x) - x
    xr, xw, xk, xv, xa, xg = [x + xx * mu[i] for i in range(N_MIX_COEF)]
    r, k, v = jnp.einsum('cbtd,cde->cbte', jnp.stack([xr, xk, xv]), w_rkv)
    w = -jax.nn.softplus(-(w0 + jnp.tanh(xw @ w1) @ w2).astype(f32)) - 0.5
    decay = jnp.exp(-jnp.exp(w))
    if vres is None:
        v_first = v
    else:
        v0, v1, v2 = vres
        v = v + (v_first - v) * jax.nn.sigmoid(v0 + (xv @ v1) @ v2)
    a = jax.nn.sigmoid(a0 + (xa @ a1) @ a2)
    g = jax.nn.sigmoid(xg @ g1) @ g2
    kk = (k * k_k).reshape(B, T, H, N).astype(f32)
    kk = kk / jnp.maximum(jnp.linalg.norm(kk, axis=-1, keepdims=True), 1e-12)
    k = k * (1.0 + (a - 1.0) * k_a)
    rh = r.reshape(B, T, H, N).astype(f32)
    kh = k.reshape(B, T, H, N).astype(f32)
    vh = v.reshape(B, T, H, N).astype(f32)
    ah = a.reshape(B, T, H, N).astype(f32)
    y = rwkv7_scan(rh, decay.reshape(B, T, H, N), kh, vh, -kk, kk * ah)
    mean = jnp.mean(y, axis=-1, keepdims=True)
    var = jnp.mean(jnp.square(y - mean), axis=-1, keepdims=True)
    y = (y - mean) * lax.rsqrt(var + GN_EPS)
    y = y.reshape(B, T, D) * lnx_w.astype(f32) + lnx_b.astype(f32)
    bonus = jnp.sum(rh * kh * r_k.astype(f32), axis=-1, keepdims=True) * vh
    y = (y + bonus.reshape(B, T, D)).astype(x.dtype)
    return (y * g) @ w_o, v_first


def swa_sink_attention(x, w_qkv, b_qkv, w_o, b_o, sinks):
    B, T, D = x.shape
    nb = T // BLOCK
    kvd = N_KV_HEADS * ATT_HEAD
    qkv = x @ w_qkv + b_qkv
    q = qkv[..., :D].reshape(B, nb, BLOCK, N_KV_HEADS, Q_PER_KV, ATT_HEAD) * (ATT_HEAD ** -0.5)
    k = qkv[..., D:D + kvd].reshape(B, nb, BLOCK, N_KV_HEADS, ATT_HEAD)
    v = qkv[..., D + kvd:].reshape(B, nb, BLOCK, N_KV_HEADS, ATT_HEAD)

    def with_prev(t):
        prev = jnp.pad(t, ((0, 0), (1, 0), (0, 0), (0, 0), (0, 0)))[:, :-1]
        return jnp.concatenate([prev, t], axis=2)

    kb, vb = with_prev(k), with_prev(v)
    logits = jnp.einsum('bnqhgd,bnkhd->bnhgqk', q, kb).astype(jnp.float32)
    blk = jnp.arange(nb)[:, None, None] * BLOCK
    qpos = blk + jnp.arange(BLOCK)[None, :, None]
    kpos = blk - BLOCK + jnp.arange(2 * BLOCK)[None, None, :]
    rel = qpos - kpos
    mask = (rel >= 0) & (rel < WINDOW) & (kpos >= 0)
    logits = jnp.where(mask[None, :, None, None], logits, -jnp.inf)
    sink = sinks.astype(jnp.float32).reshape(N_KV_HEADS, Q_PER_KV)[None, None, :, :, None]
    m = jnp.maximum(jnp.max(logits, axis=-1), sink)
    p = jnp.exp(logits - m[..., None])
    denom = jnp.sum(p, axis=-1) + jnp.exp(sink - m)
    probs = (p / denom[..., None]).astype(x.dtype)
    o = jnp.einsum('bnhgqk,bnkhd->bnqhgd', probs, vb).reshape(B, T, D)
    return o @ w_o + b_o


def short_gated_conv(x, w_in, conv_w, w_out):
    D = x.shape[-1]
    bch = x @ w_in
    bg, cg, h = bch[..., :D], bch[..., D:2 * D], bch[..., 2 * D:]
    u = cg * h
    uc = lax.conv_general_dilated(u, conv_w[:, None, :], window_strides=(1,),
                                  padding=((CONV_W - 1, 0),),
                                  dimension_numbers=('NWC', 'WIO', 'NWC'),
                                  feature_group_count=D)
    return (bg * uc) @ w_out


def sqrelu_mlp(x, w_up, w_down):
    h = jax.nn.relu(x @ w_up)
    return (h * h) @ w_down


def setup_inputs(seed: int = 0) -> dict:
    key = jax.random.key(seed)
    ks = iter(jax.random.split(key, 40))
    nrm = lambda shape, s: jax.random.normal(next(ks), shape, jnp.float32) * s
    uni = lambda shape, lo, hi: jax.random.uniform(next(ks), shape, jnp.float32, lo, hi)
    D, H, N = D_MODEL, RWKV_HEADS, RWKV_HEAD
    dsc = D ** -0.5
    kvd = N_KV_HEADS * ATT_HEAD
    return {
        "x": nrm((BATCH, SEQ, D), 1.0),
        "norm_mix": 1.0 + nrm((DEPTH, D), 0.02),
        "norm_ffn": 1.0 + nrm((DEPTH, D), 0.02),
        "norm_final": 1.0 + nrm((D,), 0.02),
        "rwkv_mu": uni((N_RWKV, N_MIX_COEF, D), 0.0, 1.0),
        "rwkv_w_rkv": nrm((N_RWKV, 3, D, D), dsc),
        "rwkv_w_o": nrm((N_RWKV, D, D), dsc),
        "rwkv_w0": uni((N_RWKV, D), -6.0, -1.0),
        "rwkv_w1": nrm((N_RWKV, D, DECAY_LORA), dsc),
        "rwkv_w2": nrm((N_RWKV, DECAY_LORA, D), 0.1 * DECAY_LORA ** -0.5),
        "rwkv_a0": nrm((N_RWKV, D), 0.5),
        "rwkv_a1": nrm((N_RWKV, D, AAA_LORA), dsc),
        "rwkv_a2": nrm((N_RWKV, AAA_LORA, D), 0.5 * AAA_LORA ** -0.5),
        "rwkv_v0": nrm((N_RWKV - 1, D), 0.5),
        "rwkv_v1": nrm((N_RWKV - 1, D, MV_LORA), dsc),
        "rwkv_v2": nrm((N_RWKV - 1, MV_LORA, D), 0.5 * MV_LORA ** -0.5),
        "rwkv_g1": nrm((N_RWKV, D, GATE_LORA), dsc),
        "rwkv_g2": nrm((N_RWKV, GATE_LORA, D), GATE_LORA ** -0.5),
        "rwkv_k_k": 1.0 + nrm((N_RWKV, D), 0.1),
        "rwkv_k_a": uni((N_RWKV, D), 0.0, 1.0),
        "rwkv_r_k": nrm((N_RWKV, H, N), 0.1),
        "rwkv_lnx_w": 1.0 + nrm((N_RWKV, D), 0.02),
        "rwkv_lnx_b": nrm((N_RWKV, D), 0.02),
        "swa_w_qkv": nrm((N_SWA, D, D + 2 * kvd), dsc),
        "swa_b_qkv": nrm((N_SWA, D + 2 * kvd), 0.02),
        "swa_w_o": nrm((N_SWA, D, D), dsc),
        "swa_b_o": nrm((N_SWA, D), 0.02),
        "swa_sinks": nrm((N_SWA, N_Q_HEADS), 1.0),
        "conv_w_in": nrm((N_CONV, D, 3 * D), dsc),
        "conv_w": nrm((N_CONV, CONV_W, D), CONV_W ** -0.5),
        "conv_w_out": nrm((N_CONV, D, D), dsc),
        "mlp_w_up": nrm((DEPTH, D, D_FF), dsc),
        "mlp_w_down": nrm((DEPTH, D_FF, D), D_FF ** -0.5),
    }


def reference(x, norm_mix, norm_ffn, norm_final,
              rwkv_mu, rwkv_w_rkv, rwkv_w_o, rwkv_w0, rwkv_w1, rwkv_w2,
              rwkv_a0, rwkv_a1, rwkv_a2, rwkv_v0, rwkv_v1, rwkv_v2,
              rwkv_g1, rwkv_g2, rwkv_k_k, rwkv_k_a, rwkv_r_k, rwkv_lnx_w, rwkv_lnx_b,
              swa_w_qkv, swa_b_qkv, swa_w_o, swa_b_o, swa_sinks,
              conv_w_in, conv_w, conv_w_out,
              mlp_w_up, mlp_w_down):
    v_first = None
    ia = ib = ic = 0
    for i in range(DEPTH):
        h = rms_norm(x, norm_mix[i])
        kind = i % N_MIXERS
        if kind == 0:
            vres = None if ia == 0 else (rwkv_v0[ia - 1], rwkv_v1[ia - 1], rwkv_v2[ia - 1])
            out, v_first = rwkv7_time_mix(
                h, v_first, rwkv_mu[ia], rwkv_w_rkv[ia], rwkv_w_o[ia],
                rwkv_w0[ia], rwkv_w1[ia], rwkv_w2[ia],
                rwkv_a0[ia], rwkv_a1[ia], rwkv_a2[ia],
                rwkv_g1[ia], rwkv_g2[ia], rwkv_k_k[ia], rwkv_k_a[ia], rwkv_r_k[ia],
                rwkv_lnx_w[ia], rwkv_lnx_b[ia], vres)
            ia += 1
        elif kind == 1:
            out = swa_sink_attention(h, swa_w_qkv[ib], swa_b_qkv[ib], swa_w_o[ib],
                                     swa_b_o[ib], swa_sinks[ib])
            ib += 1
        else:
            out = short_gated_conv(h, conv_w_in[ic], conv_w[ic], conv_w_out[ic])
            ic += 1
        x = x + out
        x = x + sqrelu_mlp(rms_norm(x, norm_ffn[i]), mlp_w_up[i], mlp_w_down[i])
    return rms_norm(x, norm_final)
```

```cpp
#include <hip/hip_runtime.h>
#include <hip/hip_cooperative_groups.h>
#include <cstdio>
#include <cstdint>
namespace cg = cooperative_groups;

#define LAS __attribute__((address_space(3)))
#define DI __device__ __forceinline__
typedef unsigned short bf16_t;
typedef short bf16x8 __attribute__((ext_vector_type(8)));
typedef float f32x4 __attribute__((ext_vector_type(4)));
typedef float f32x2 __attribute__((ext_vector_type(2)));
typedef float f32x16 __attribute__((ext_vector_type(16)));
typedef unsigned u32x4 __attribute__((ext_vector_type(4)));
typedef unsigned u32x2 __attribute__((ext_vector_type(2)));

constexpr int DM = 2048, NB = 4, SEQ = 4096, MTOK = NB * SEQ, DFF = 8192, DEPTH = 4;
constexpr int NTHREADS = 512, NWAVES = 8;
constexpr int LDS_BYTES = 147456;
constexpr size_t MiB = (size_t)1 << 20;
constexpr size_t WS_RW0 = 1 * MiB, WS_RW1 = 41 * MiB, WS_SWA = 81 * MiB, WS_CONV = 99 * MiB, WS_MLP = 131 * MiB, WS_VFIRST = 195 * MiB, WS_AR = 259 * MiB;
constexpr size_t WS_NEED = 1008 * MiB;
constexpr size_t WS_MLP2 = 944 * MiB;
constexpr size_t E_M = (size_t)1 << 20;
constexpr size_t RW_WR = 0, RW_WK = 4 * E_M, RW_WV = 8 * E_M, RW_L1 = 12 * E_M, RW_W2 = 14 * E_M, RW_A2 = 14 * E_M + 256 * 1024, RW_G2 = 14 * E_M + 512 * 1024,
                 RW_V2 = 15 * E_M, RW_WO = 15 * E_M + 256 * 1024;

DI unsigned f2bf(float f) { unsigned u = __builtin_bit_cast(unsigned, f); return (u + 0x7fffu + ((u >> 16) & 1u)) >> 16; }
DI unsigned pk2(float lo, float hi) { unsigned r; asm volatile("v_cvt_pk_bf16_f32 %0, %1, %2" : "=v"(r) : "v"(lo), "v"(hi)); return r; }
DI float bflo(unsigned u) { return __builtin_bit_cast(float, u << 16); }
DI float bfhi(unsigned u) { return __builtin_bit_cast(float, u & 0xffff0000u); }
DI float sigmoidf_(float x) { return 1.0f / (1.0f + __expf(-x)); }
DI int lane_opaque() { int l; asm volatile("v_mbcnt_lo_u32_b32 %0, -1, 0\n\tv_mbcnt_hi_u32_b32 %0, -1, %0" : "=v"(l)); return l; }
#define TID_OF(a) ((a).w0 * 64 + lane_opaque())
template <int CTRL> DI float dppf(float v) { return __builtin_bit_cast(float, __builtin_amdgcn_update_dpp(0, __builtin_bit_cast(int, v), CTRL, 0xF, 0xF, true)); }
DI float rowsum16(float v) { v += dppf<0xB1>(v); v += dppf<0x4E>(v); v += dppf<0x141>(v); v += dppf<0x140>(v); return v; }
DI float wave_sum(float v) {
    v = rowsum16(v);
    const int u = __builtin_bit_cast(int, v);
    return (__builtin_bit_cast(float, __builtin_amdgcn_readlane(u, 0)) + __builtin_bit_cast(float, __builtin_amdgcn_readlane(u, 16))) +
           (__builtin_bit_cast(float, __builtin_amdgcn_readlane(u, 32)) + __builtin_bit_cast(float, __builtin_amdgcn_readlane(u, 48)));
}
DI float xor32(float v, int lane) { return __builtin_bit_cast(float, __builtin_amdgcn_ds_bpermute((lane ^ 32) << 2, __builtin_bit_cast(int, v))); }

namespace pg8 {
constexpr int BM = 256, BK = 64, HALF = 128, HTB = HALF * BK * 2, STAGE_BYTES = 8 * HTB, NXCD = 8, WGM = 8;
__host__ __device__ __forceinline__ int lds_byte(int r, int c) { const int st = (r >> 4) * 2 + (c >> 5), rr = r & 15, cc = c & 31, ob = rr * 64 + cc * 2; return st * 1024 + (ob ^ (((ob >> 9) & 1) << 5)); }
__host__ __device__ __forceinline__ void stage_rc(int b, int& R, int& C) { const int st = b / 1024, sb = b % 1024, swz = sb ^ (((sb >> 9) & 1) << 5); R = (st >> 1) * 16 + swz / 64; C = (st & 1) * 32 + (swz % 64) / 2; }
__host__ __device__ __forceinline__ int perm32(int rho) { const int n = rho >> 4, i = rho & 15; return 8 * (i >> 2) + 4 * n + (i & 3); }

struct Unit { int pm, pn; };
struct Gemm { const bf16_t* A; const bf16_t* Bt; int lda, ldb, N, K; };

struct StaticOrder {
    int nM, nN, nwg, G, c;
    DI void init(int M, int N, int G_, int c_) { nM = M / BM; nN = N / BM; nwg = nM * nN; G = G_; c = c_; }
    DI bool next(int i, Unit& u) const {
        const long L = (long)i * G + c; if (L >= nwg) return false;
        int wgid = (int)L; { const int q = nwg / NXCD, r = nwg % NXCD, xcd = wgid % NXCD, off = wgid / NXCD; wgid = (xcd < r ? xcd * (q + 1) : r * (q + 1) + (xcd - r) * q) + off; }
        const int nig = WGM * nN, gid = wgid / nig, fm = gid * WGM, gsz = (nM - fm) < WGM ? (nM - fm) : WGM;
        u.pm = fm + ((wgid % nig) % gsz); u.pn = (wgid % nig) / gsz; return true;
    }
};

enum { EM_BF16 = 0, EM_VMIX = 1, EM_RESID = 2, EM_DECAY = 3 };
enum { ACT_NONE = 0, ACT_RELU2 = 1, ACT_TANH = 2, ACT_SIGMOID = 3 };
struct Epi {
    int mode, act; void* out; int ldc; const float* bias; const void* p1; int qcols; int dry;
    DI bool perm() const { return mode == EM_BF16 || mode == EM_VMIX; }
    DI float actf(float v) const {
        if (act == ACT_RELU2) { v = v > 0.f ? v : 0.f; return v * v; }
        if (act == ACT_TANH) { const float e = __expf(2.f * v); return 1.f - 2.f / (e + 1.f); }
        if (act == ACT_SIGMOID) return sigmoidf_(v);
        return v;
    }
    template <int ACT> static DI float act_c(float v) {
        if (ACT == ACT_RELU2) { v = v > 0.f ? v : 0.f; return v * v; }
        if (ACT == ACT_TANH) { const float e = __expf(2.f * v); return 1.f - 2.f / (e + 1.f); }
        if (ACT == ACT_SIGMOID) return sigmoidf_(v);
        return v;
    }
    template <int ACT  > DI void perm_body(const f32x4 (&acc)[2][2][4][2], const f32x4 (&bv)[2][2], const int row0, const int col0) const {
#pragma unroll
        for (int ai = 0; ai < 2; ++ai)
#pragma unroll
            for (int m = 0; m < 4; ++m) {
                const size_t roff = (size_t)(row0 + ai * HALF + m * 16) * ldc + col0;
#pragma unroll
                for (int bj = 0; bj < 2; ++bj) {
                    const f32x4 v0 = acc[ai][bj][m][0] + bv[bj][0], v1 = acc[ai][bj][m][1] + bv[bj][1];
                    bf16_t* op = (bf16_t*)out + roff + bj * HALF;
                    u32x4 w;
                    if (ACT == -1) {
                        const u32x4 vc = *(const u32x4*)op, vf = *(const u32x4*)((const bf16_t*)p1 + roff + bj * HALF);
                        const float g[8] = {sigmoidf_(v0[0]), sigmoidf_(v0[1]), sigmoidf_(v0[2]), sigmoidf_(v0[3]), sigmoidf_(v1[0]), sigmoidf_(v1[1]), sigmoidf_(v1[2]), sigmoidf_(v1[3])};
#pragma unroll
                        for (int q = 0; q < 4; ++q) { const float c0 = bflo(vc[q]), c1 = bfhi(vc[q]), f0 = bflo(vf[q]), f1 = bfhi(vf[q]);
                            w[q] = pk2(c0 + (f0 - c0) * g[2 * q], c1 + (f1 - c1) * g[2 * q + 1]); }
                    } else {
                        const float sc = (col0 + bj * HALF) < qcols ? 0.125f : 1.0f;
                        w.x = pk2(act_c<ACT>(v0[0]) * sc, act_c<ACT>(v0[1]) * sc); w.y = pk2(act_c<ACT>(v0[2]) * sc, act_c<ACT>(v0[3]) * sc);
                        w.z = pk2(act_c<ACT>(v1[0]) * sc, act_c<ACT>(v1[1]) * sc); w.w = pk2(act_c<ACT>(v1[2]) * sc, act_c<ACT>(v1[3]) * sc);
                    }
                    *(u32x4*)op = w;
                }
            }
    }
    DI void operator()(const f32x4 (&acc)[2][2][4][2], const Unit& u, const int wid) const {
        const int lane = lane_opaque(), wr = wid >> 2, wc = wid & 3, fr = lane & 15, fq = lane >> 4;
        const int row0 = u.pm * BM + wr * 64 + fr;
        if (perm()) {
            const int col0 = u.pn * BM + wc * 32 + 8 * fq;
            f32x4 bv[2][2];
#pragma unroll
            for (int bj = 0; bj < 2; ++bj)
#pragma unroll
                for (int n = 0; n < 2; ++n) bv[bj][n] = bias ? *(const f32x4*)(bias + col0 + bj * HALF + 4 * n) : (f32x4){0.f, 0.f, 0.f, 0.f};
            if (mode == EM_VMIX) perm_body<-1>(acc, bv, row0, col0);
            else if (act == ACT_RELU2) perm_body<ACT_RELU2>(acc, bv, row0, col0);
            else if (act == ACT_TANH) perm_body<ACT_TANH>(acc, bv, row0, col0);
            else if (act == ACT_SIGMOID) perm_body<ACT_SIGMOID>(acc, bv, row0, col0);
            else perm_body<ACT_NONE>(acc, bv, row0, col0);
        } else {
            const int col0 = u.pn * BM + wc * 32 + 4 * fq;
            if (mode == EM_RESID) { if (dry) flat_body<2>(acc, row0, col0); else flat_body<0>(acc, row0, col0); }
            else flat_body<1>(acc, row0, col0);
        }
    }
    template <int W  > DI void flat_body(const f32x4 (&acc)[2][2][4][2], const int row0, const int col0) const {
#pragma unroll
        for (int bj = 0; bj < 2; ++bj)
#pragma unroll
            for (int n = 0; n < 2; ++n) {
                const int col = col0 + bj * HALF + n * 16;
                const f32x4 bv = bias ? *(const f32x4*)(bias + col) : (f32x4){0.f, 0.f, 0.f, 0.f};
#pragma unroll
                for (int ai = 0; ai < 2; ++ai)
#pragma unroll
                    for (int m = 0; m < 4; ++m) {
                        const size_t off = (size_t)(row0 + ai * HALF + m * 16) * ldc + col;
                        f32x4 v = acc[ai][bj][m][n] + bv;
                        if (W == 0) v = v + *(const f32x4*)((const float*)p1 + off);
                        else if (W == 2) v = *(const f32x4*)((const float*)out + off) + 0.0f * v;
                        else { v[0] = __expf(-0.60653066f * sigmoidf_(v[0])); v[1] = __expf(-0.60653066f * sigmoidf_(v[1])); v[2] = __expf(-0.60653066f * sigmoidf_(v[2])); v[3] = __expf(-0.60653066f * sigmoidf_(v[3])); }
                        *(f32x4*)((float*)out + off) = v;
                    }
            }
    }
};

template <class Sched>
DI void gemm_phase(LAS unsigned char* lds, const Gemm g, const Sched& S, const Epi& E, const int wid) {
    const int lane = lane_opaque(), tid = wid * 64 + lane, wr = wid >> 2, wc = wid & 3, fr = lane & 15, fq = lane >> 4;
    const int K = g.K, nt = K / BK;
    const bool PERM = E.perm();
    unsigned voffA[2], voffB[2];
#pragma unroll
    for (int i = 0; i < 2; ++i) { int R, C; stage_rc(tid * 16 + i * 8192, R, C); const int Rb = PERM ? ((R & ~31) + perm32(R & 31)) : R;
        voffA[i] = (unsigned)(R * g.lda + C) * 2u; voffB[i] = (unsigned)(Rb * g.ldb + C) * 2u; }
    const size_t kstep = (size_t)(BK * 2);
    const size_t hstepA = (size_t)HALF * g.lda * 2, hstepB = (size_t)HALF * g.ldb * 2;
    const size_t tstepA = 2 * hstepA, tstepB = 2 * hstepB;
    const unsigned ldsw = (unsigned)wid * 1024u;
    const int aoff = lds_byte(wr * 64 + fr, fq * 8), boff = lds_byte(wc * 32 + fr, fq * 8);
#define PG8_SA(b, h) (((b) * 2 + (h)) * HTB)
#define PG8_SB(b, h) ((4 + (b) * 2 + (h)) * HTB)
#define PG8_STAGE(bufoff, gbase, voff) do { _Pragma("unroll") for (int _i = 0; _i < 2; ++_i) \
        __builtin_amdgcn_global_load_lds((const unsigned*)((const char*)(gbase) + (voff)[_i]), (LAS unsigned*)(lds + (bufoff) + ldsw + _i * 8192), 16, 0, 0); } while (0)
#define PG8_LDA(dst, b, h) do { _Pragma("unroll") for (int m = 0; m < 4; ++m) _Pragma("unroll") for (int k = 0; k < 2; ++k) dst[m][k] = *(const LAS bf16x8*)(lds + PG8_SA(b, h) + aoff + m * 2048 + k * 1024); } while (0)
#define PG8_LDB(dst, b, h) do { _Pragma("unroll") for (int n = 0; n < 2; ++n) _Pragma("unroll") for (int k = 0; k < 2; ++k) dst[n][k] = *(const LAS bf16x8*)(lds + PG8_SB(b, h) + boff + n * 2048 + k * 1024); } while (0)
#define PG8_MMA(ai, bj, At, Bt) do { __builtin_amdgcn_s_setprio(1); _Pragma("unroll") for (int m = 0; m < 4; ++m) _Pragma("unroll") for (int n = 0; n < 2; ++n) _Pragma("unroll") for (int k = 0; k < 2; ++k) \
        acc[ai][bj][m][n] = __builtin_amdgcn_mfma_f32_16x16x32_bf16(Bt[n][k], At[m][k], acc[ai][bj][m][n], 0, 0, 0); __builtin_amdgcn_s_setprio(0); } while (0)
#define PG8_WAIT_V(n) asm volatile("s_waitcnt vmcnt(" #n ")" ::: "memory")
#define PG8_WAIT_L(n) asm volatile("s_waitcnt lgkmcnt(" #n ")" ::: "memory")
#define PG8_BAR __builtin_amdgcn_s_barrier()
#define PG8_SCHED __builtin_amdgcn_sched_barrier(0)
    Unit cur, nxt; int ui = 0;
    if (!S.next(0, cur)) return;
    f32x4 acc[2][2][4][2];
#pragma unroll
    for (int a = 0; a < 2; ++a)
#pragma unroll
        for (int b = 0; b < 2; ++b)
#pragma unroll
            for (int m = 0; m < 4; ++m)
#pragma unroll
                for (int n = 0; n < 2; ++n) acc[a][b][m][n] = (f32x4){0.f, 0.f, 0.f, 0.f};
    bf16x8 At[4][2], B0[2][2], B1[2][2];
    const char* cA = (const char*)g.A + (size_t)cur.pm * tstepA; const char* cB = (const char*)g.Bt + (size_t)cur.pn * tstepB;
    PG8_STAGE(PG8_SB(0, 0), cB, voffB); PG8_STAGE(PG8_SB(0, 1), cB + hstepB, voffB); PG8_STAGE(PG8_SA(0, 0), cA, voffA); PG8_STAGE(PG8_SA(0, 1), cA + hstepA, voffA);
    if (wr == 1) PG8_BAR;
    PG8_WAIT_V(2); PG8_BAR;
    PG8_STAGE(PG8_SB(1, 0), cB + kstep, voffB); PG8_STAGE(PG8_SA(1, 0), cA + kstep, voffA); PG8_STAGE(PG8_SB(1, 1), cB + hstepB + kstep, voffB);
    PG8_WAIT_V(6); PG8_BAR;
    for (;;) {
        const bool has_next = S.next(ui + 1, nxt);
        const char* nA = has_next ? (const char*)g.A + (size_t)nxt.pm * tstepA : cA; const char* nB = has_next ? (const char*)g.Bt + (size_t)nxt.pn * tstepB : cB;
        for (int t = 0; t < nt; t += 2) {
            const bool last = (t == nt - 2);
            const char* a1 = cA + (size_t)(t + 1) * kstep;
            const char* a2 = last ? nA : cA + (size_t)(t + 2) * kstep; const char* b2 = last ? nB : cB + (size_t)(t + 2) * kstep;
            const char* a3 = a2 + kstep; const char* b3 = b2 + kstep;
            PG8_LDB(B0, 0, 0); PG8_LDB(B1, 0, 1); PG8_SCHED; PG8_LDA(At, 0, 0); PG8_STAGE(PG8_SA(1, 1), a1 + hstepA, voffA);
            PG8_WAIT_V(8); PG8_WAIT_L(0); PG8_BAR; PG8_MMA(0, 0, At, B0); PG8_MMA(0, 1, At, B1); PG8_BAR; PG8_SCHED;
            PG8_LDA(At, 0, 1); PG8_STAGE(PG8_SB(0, 0), b2, voffB); PG8_STAGE(PG8_SB(0, 1), b2 + hstepB, voffB); PG8_STAGE(PG8_SA(0, 0), a2, voffA);
            PG8_WAIT_V(8); PG8_WAIT_L(0); PG8_BAR; PG8_MMA(1, 0, At, B0); PG8_MMA(1, 1, At, B1); PG8_BAR; PG8_SCHED;
            PG8_LDB(B0, 1, 0); PG8_LDB(B1, 1, 1); PG8_SCHED; PG8_LDA(At, 1, 0); PG8_STAGE(PG8_SA(0, 1), a2 + hstepA, voffA);
            PG8_WAIT_V(8); PG8_WAIT_L(0); PG8_BAR; PG8_MMA(0, 0, At, B0); PG8_MMA(0, 1, At, B1); PG8_BAR; PG8_SCHED;
            PG8_LDA(At, 1, 1); PG8_STAGE(PG8_SB(1, 0), b3, voffB); PG8_STAGE(PG8_SB(1, 1), b3 + hstepB, voffB); PG8_STAGE(PG8_SA(1, 0), a3, voffA);
            PG8_WAIT_V(8); PG8_WAIT_L(0); PG8_BAR; PG8_MMA(1, 0, At, B0); PG8_MMA(1, 1, At, B1); PG8_BAR; PG8_SCHED;
        }
        if (wr == 0) PG8_BAR;
        E(acc, cur, wid);
        if (!has_next) break;
#pragma unroll
        for (int a = 0; a < 2; ++a)
#pragma unroll
            for (int b = 0; b < 2; ++b)
#pragma unroll
                for (int m = 0; m < 4; ++m)
#pragma unroll
                    for (int n = 0; n < 2; ++n) acc[a][b][m][n] = (f32x4){0.f, 0.f, 0.f, 0.f};
        cur = nxt; cA = nA; cB = nB; ++ui;
        if (wr == 1) PG8_BAR;
    }
    PG8_WAIT_V(0);
    PG8_BAR;
#undef PG8_SA
#undef PG8_SB
#undef PG8_STAGE
#undef PG8_LDA
#undef PG8_LDB
#undef PG8_MMA
#undef PG8_WAIT_V
#undef PG8_WAIT_L
#undef PG8_BAR
#undef PG8_SCHED
}
}

struct Args { const float* in[33]; float* out; unsigned char* ws; int op_lo, op_hi; };
struct Ctx { float* out; unsigned char* ws; int bid, G, w0; };
DI const float* inp_(const Args& a, int i) { return a.in[i]; }
DI const float* inp_(const Ctx& a, int i) {
    const unsigned* p = (const unsigned*)a.ws + 2 * i;
    const unsigned long long lo = (unsigned)__builtin_amdgcn_readfirstlane((int)p[0]), hi = (unsigned)__builtin_amdgcn_readfirstlane((int)p[1]);
    return (const float*)(lo | (hi << 32));
}
#define INP(a, i) inp_(a, i)

enum { K_PROLOGUE = 0, K_GEMM, K_MIX, K_NORM, K_SCAN, K_GNGATE, K_ATTN, K_CONVGATE, K_FINAL };
struct Op {
    int kind, sync;
    const bf16_t* A; const bf16_t* Bt; int lda, ldb, N, K, shift;
    int emode, act; void* out; int ldc; const float* bias; const void* p1; int qcols;
    int layer, idx;
    const float* xin;
    int pad_[4];
};
static_assert(sizeof(Op) == 128, "Op is one 128-byte record");
constexpr size_t WS_OPTAB = 4096;

constexpr int NOPS_RWKV0 = 13, NOPS_RWKV1 = 15, NOPS_SWA = 4, NOPS_CONV = 4, NOPS_FFN = 3;
constexpr int NOPS_TOTAL = 1 + (NOPS_RWKV0 + NOPS_FFN) + (NOPS_SWA + NOPS_FFN) + (NOPS_CONV + NOPS_FFN) + (NOPS_RWKV1 + NOPS_FFN) + 1;

DI void set_gemm(Op& d, const bf16_t* A, int lda, const bf16_t* Bt, int ldb, int N, int K, int shift,
                                                  int emode, int act, void* out, int ldc, const float* bias, const void* p1, int qcols, int sync) {
    d.kind = K_GEMM; d.A = A; d.lda = lda; d.Bt = Bt; d.ldb = ldb; d.N = N; d.K = K; d.shift = shift; d.emode = emode; d.act = act; d.out = out; d.ldc = ldc; d.bias = bias; d.p1 = p1; d.qcols = qcols; d.sync = sync;
}

template <class AT> DI void ffn_ops(Op& d, int o, int L, const AT& a) {
    unsigned char* ws = a.ws; float* X = a.out;
    bf16_t* H = (bf16_t*)(ws + WS_AR); bf16_t* HID = (bf16_t*)(ws + WS_AR + 64 * MiB);
    bf16_t* WUP = (bf16_t*)(ws + (L == 1 ? WS_MLP2 : WS_MLP)); bf16_t* WDN = WUP + (size_t)16 * E_M;
    if (o == 0) { d.kind = K_NORM; d.sync = 1; d.layer = L; d.idx = 1; d.xin = X; }
    else if (o == 1) set_gemm(d, H, DM, WUP, DM, DFF, DM, 0, pg8::EM_BF16, pg8::ACT_RELU2, HID, DFF, nullptr, nullptr, 0, 1);
    else set_gemm(d, HID, DFF, WDN, DFF, DM, DFF, 0, pg8::EM_RESID, 0, X, DM, nullptr, X, 0, 1);
}

template <class AT> DI void rwkv_ops(Op& d, int o, int L, int ia, const AT& a) {
    unsigned char* ws = a.ws; float* X = a.out;
    bf16_t* RW = (bf16_t*)(ws + (ia == 0 ? WS_RW0 : WS_RW1));
    unsigned char* AR = ws + WS_AR;
    bf16_t *XR = (bf16_t*)(AR), *XK = (bf16_t*)(AR + 64 * MiB), *XV = (bf16_t*)(AR + 128 * MiB), *XW = (bf16_t*)(AR + 192 * MiB), *XA = (bf16_t*)(AR + 256 * MiB), *XG = (bf16_t*)(AR + 320 * MiB);
    bf16_t *R = (bf16_t*)(AR + 384 * MiB), *Kb = (bf16_t*)(AR + 448 * MiB), *Vb = (bf16_t*)(ia == 0 ? ws + WS_VFIRST : AR + 512 * MiB), *L1 = (bf16_t*)(AR + 576 * MiB), *YG = (bf16_t*)(AR + 608 * MiB);
    float* DEC = (float*)(AR); bf16_t* AG = (bf16_t*)(AR + 128 * MiB); bf16_t* G = (bf16_t*)(AR + 192 * MiB);
    const float* xin = (L == 0) ? INP(a, 0) : X;
    const int hasv = ia;
    d.layer = L; d.idx = ia; d.xin = xin;
    int k = o;
    if (k == 0) { d.kind = K_MIX; d.sync = 1; return; }
    k -= 1;
    if (k == 0) { set_gemm(d, XR, DM, RW + RW_WR, DM, DM, DM, 0, pg8::EM_BF16, 0, R, DM, nullptr, nullptr, 0, 0); return; }
    if (k == 1) { set_gemm(d, XK, DM, RW + RW_WK, DM, DM, DM, 0, pg8::EM_BF16, 0, Kb, DM, nullptr, nullptr, 0, 0); return; }
    if (k == 2) { set_gemm(d, XV, DM, RW + RW_WV, DM, DM, DM, 0, pg8::EM_BF16, 0, Vb, DM, nullptr, nullptr, 0, 0); return; }
    if (k == 3) { set_gemm(d, XW, DM, RW + RW_L1, DM, 256, DM, 0, pg8::EM_BF16, pg8::ACT_TANH, L1, 1024, nullptr, nullptr, 0, 0); return; }
    if (k == 4) { set_gemm(d, XA, DM, RW + RW_L1 + 256 * DM, DM, 256, DM, 64, pg8::EM_BF16, 0, L1 + 256, 1024, nullptr, nullptr, 0, 0); return; }
    if (k == 5) { set_gemm(d, XG, DM, RW + RW_L1 + 512 * DM, DM, 256, DM, 128, pg8::EM_BF16, pg8::ACT_SIGMOID, L1 + 512, 1024, nullptr, nullptr, 0, hasv ? 0 : 1); return; }
    k -= 6;
    if (hasv) { if (k == 0) { set_gemm(d, XV, DM, RW + RW_L1 + 768 * DM, DM, 256, DM, 192, pg8::EM_BF16, 0, L1 + 768, 1024, nullptr, nullptr, 0, 1); return; } k -= 1; }
    if (k == 0) { set_gemm(d, L1, 1024, RW + RW_W2, 128, DM, 128, 0, pg8::EM_DECAY, 0, DEC, DM, INP(a, 7) + ia * DM, nullptr, 0, 0); return; }
    if (k == 1) { set_gemm(d, L1 + 256, 1024, RW + RW_A2, 128, DM, 128, 0, pg8::EM_BF16, pg8::ACT_SIGMOID, AG, DM, INP(a, 10) + ia * DM, nullptr, 0, 0); return; }
    if (k == 2) { set_gemm(d, L1 + 512, 1024, RW + RW_G2, 256, DM, 256, 0, pg8::EM_BF16, 0, G, DM, nullptr, nullptr, 0, hasv ? 0 : 1); return; }
    k -= 3;
    if (hasv) { if (k == 0) { set_gemm(d, L1 + 768, 1024, RW + RW_V2, 128, DM, 128, 0, pg8::EM_VMIX, 0, Vb, DM, INP(a, 13), ws + WS_VFIRST, 0, 1); return; } k -= 1; }
    if (k == 0) { d.kind = K_SCAN; d.sync = 1; return; }
    if (k == 1) { d.kind = K_GNGATE; d.sync = 1; return; }
    set_gemm(d, YG, DM, RW + RW_WO, DM, DM, DM, 0, pg8::EM_RESID, 0, X, DM, nullptr, xin, 0, 1);
}

template <class AT> DI void swa_ops(Op& d, int o, int L, const AT& a) {
    unsigned char* ws = a.ws; float* X = a.out; unsigned char* AR = ws + WS_AR;
    bf16_t* H = (bf16_t*)AR; bf16_t* QKV = (bf16_t*)(AR + 64 * MiB); bf16_t* O = (bf16_t*)(AR + 144 * MiB);
    bf16_t* WQKV = (bf16_t*)(ws + WS_SWA); bf16_t* WO = (bf16_t*)(ws + WS_SWA + 10 * MiB);
    d.layer = L; d.idx = 0; d.xin = X;
    if (o == 0) { d.kind = K_NORM; d.sync = 1; d.idx = 0; return; }
    if (o == 1) { set_gemm(d, H, DM, WQKV, DM, 2560, DM, 0, pg8::EM_BF16, 0, QKV, 2560, INP(a, 24), nullptr, 2048, 1); return; }
    if (o == 2) { d.kind = K_ATTN; d.sync = 1; return; }
    set_gemm(d, O, DM, WO, DM, DM, DM, 0, pg8::EM_RESID, 0, X, DM, INP(a, 26), X, 0, 1);
}

template <class AT> DI void conv_ops(Op& d, int o, int L, const AT& a) {
    unsigned char* ws = a.ws; float* X = a.out; unsigned char* AR = ws + WS_AR;
    bf16_t* H = (bf16_t*)AR; bf16_t* BCH = (bf16_t*)(AR + 64 * MiB); bf16_t* Z = (bf16_t*)(AR + 256 * MiB);
    bf16_t* WIN = (bf16_t*)(ws + WS_CONV); bf16_t* WOUT = (bf16_t*)(ws + WS_CONV + 24 * MiB);
    d.layer = L; d.idx = 0; d.xin = X;
    if (o == 0) { d.kind = K_NORM; d.sync = 1; d.idx = 0; return; }
    if (o == 1) { set_gemm(d, H, DM, WIN, DM, 6144, DM, 0, pg8::EM_BF16, 0, BCH, 6144, nullptr, nullptr, 0, 1); return; }
    if (o == 2) { d.kind = K_CONVGATE; d.sync = 1; return; }
    set_gemm(d, Z, DM, WOUT, DM, DM, DM, 0, pg8::EM_RESID, 0, X, DM, nullptr, X, 0, 1);
}

template <class AT> DI void build_op(Op& d, int op, const AT& a) {
    d.kind = K_FINAL; d.sync = 0; d.A = nullptr; d.Bt = nullptr; d.lda = d.ldb = d.N = d.K = d.shift = 0; d.emode = d.act = 0; d.out = nullptr; d.ldc = 0; d.bias = nullptr; d.p1 = nullptr; d.qcols = 0;
    d.layer = 0; d.idx = 0; d.xin = a.out;
    int o = op;
    if (o == 0) { d.kind = K_PROLOGUE; d.sync = 1; return; }
    o -= 1;
    if (o < NOPS_RWKV0) { rwkv_ops(d, o, 0, 0, a); return; } o -= NOPS_RWKV0;
    if (o < NOPS_FFN) { ffn_ops(d, o, 0, a); return; } o -= NOPS_FFN;
    if (o < NOPS_SWA) { swa_ops(d, o, 1, a); return; } o -= NOPS_SWA;
    if (o < NOPS_FFN) { ffn_ops(d, o, 1, a); return; } o -= NOPS_FFN;
    if (o < NOPS_CONV) { conv_ops(d, o, 2, a); return; } o -= NOPS_CONV;
    if (o < NOPS_FFN) { ffn_ops(d, o, 2, a); return; } o -= NOPS_FFN;
    if (o < NOPS_RWKV1) { rwkv_ops(d, o, 3, 1, a); return; } o -= NOPS_RWKV1;
    if (o < NOPS_FFN) { ffn_ops(d, o, 3, a); return; } o -= NOPS_FFN;
    d.kind = K_FINAL; d.sync = 0;
}

DI void tr_load(const float* W, int Ks, int Ns, int item, int nblk, int lane, f32x4 (&v)[8]) {
    const int kb = item / nblk, nb = item % nblk, k0 = 64 * kb, n0 = 32 * nb;
    const int nn = (lane & 7) * 4; const bool nok = n0 < Ns;
#pragma unroll
    for (int i = 0; i < 8; ++i) {
        const int k = k0 + i * 8 + (lane >> 3);
        v[i] = (f32x4){0.f, 0.f, 0.f, 0.f};
        if (nok && k < Ks) v[i] = *(const f32x4*)(W + (size_t)k * Ns + n0 + nn);
    }
}
DI void tr_finish(bf16_t* WT, int Kd, float* scr, int item, int nblk, int lane, const f32x4 (&v)[8]) {
    const int kb = item / nblk, nb = item % nblk, k0 = 64 * kb, n0 = 32 * nb;
    const int nn = (lane & 7) * 4;
#pragma unroll
    for (int i = 0; i < 8; ++i) { float* sp = scr + (i * 8 + (lane >> 3)) * 33 + nn; sp[0] = v[i][0]; sp[1] = v[i][1]; sp[2] = v[i][2]; sp[3] = v[i][3]; }
    asm volatile("s_waitcnt lgkmcnt(0)" ::: "memory");
    const int c = lane & 7;
#pragma unroll
    for (int j = 0; j < 4; ++j) { const int nr = (lane >> 3) + 8 * j; const float* s = scr + (8 * c) * 33 + nr;
        u32x4 o; o.x = pk2(s[0 * 33], s[1 * 33]); o.y = pk2(s[2 * 33], s[3 * 33]); o.z = pk2(s[4 * 33], s[5 * 33]); o.w = pk2(s[6 * 33], s[7 * 33]);
        *(u32x4*)(WT + (size_t)(n0 + nr) * Kd + k0 + 8 * c) = o; }
    asm volatile("s_waitcnt lgkmcnt(0)" ::: "memory");
}
DI void convert_w(const float* W, int Ks, int Ns, bf16_t* WT, int Kd, int Nd, float* scr, int gw, int NGW, int lane) {
    const int nblk = Nd / 32, nitems = (Kd / 64) * nblk;
    f32x4 cur[8], nxt[8];
    if (gw < nitems) tr_load(W, Ks, Ns, gw, nblk, lane, cur);
    for (int it = gw; it < nitems; it += NGW) {
        if (it + NGW < nitems) tr_load(W, Ks, Ns, it + NGW, nblk, lane, nxt);
        tr_finish(WT, Kd, scr, it, nblk, lane, cur);
#pragma unroll
        for (int i = 0; i < 8; ++i) cur[i] = nxt[i];
    }
}

struct CvJob { const float* W; bf16_t* WT; int Ks, Ns, Kd, nblk, nitems; };
DI void cv_set(CvJob& j, const float* W, int Ks, int Ns, bf16_t* WT, int Kd, int Nd) { j.W = W; j.WT = WT; j.Ks = Ks; j.Ns = Ns; j.Kd = Kd; j.nblk = Nd / 32; j.nitems = (Kd / 64) * (Nd / 32); }
constexpr int CV_NJOBS = 28;
DI void cv_job(CvJob& j, int id, const Args& a) {
    unsigned char* ws = a.ws; const size_t DD = (size_t)DM * DM;
    if (id < 24) {
        const int ia = id / 12, k = id % 12;
        bf16_t* RW = (bf16_t*)(ws + (ia == 0 ? WS_RW0 : WS_RW1));
        if (k < 3) cv_set(j, a.in[5] + (size_t)(ia * 3 + k) * DD, DM, DM, RW + RW_WR + (size_t)k * 4 * E_M, DM, DM);
        else if (k == 3) cv_set(j, a.in[8] + (size_t)ia * DM * 96, DM, 96, RW + RW_L1, DM, 256);
        else if (k == 4) cv_set(j, a.in[11] + (size_t)ia * DM * 96, DM, 96, RW + RW_L1 + 256 * DM, DM, 256);
        else if (k == 5) cv_set(j, a.in[16] + (size_t)ia * DM * 256, DM, 256, RW + RW_L1 + 512 * DM, DM, 256);
        else if (k == 6) cv_set(j, a.in[14], DM, 64, RW + RW_L1 + 768 * DM, DM, ia == 1 ? 256 : 0);
        else if (k == 7) cv_set(j, a.in[9] + (size_t)ia * 96 * DM, 96, DM, RW + RW_W2, 128, DM);
        else if (k == 8) cv_set(j, a.in[12] + (size_t)ia * 96 * DM, 96, DM, RW + RW_A2, 128, DM);
        else if (k == 9) cv_set(j, a.in[17] + (size_t)ia * 256 * DM, 256, DM, RW + RW_G2, 256, DM);
        else if (k == 10) cv_set(j, a.in[15], 64, DM, RW + RW_V2, 128, ia == 1 ? DM : 0);
        else cv_set(j, a.in[6] + (size_t)ia * DD, DM, DM, RW + RW_WO, DM, DM);
    } else if (id == 24) cv_set(j, a.in[23], DM, 2560, (bf16_t*)(ws + WS_SWA), DM, 2560);
    else if (id == 25) cv_set(j, a.in[25], DM, DM, (bf16_t*)(ws + WS_SWA + 10 * MiB), DM, DM);
    else if (id == 26) cv_set(j, a.in[28], DM, 6144, (bf16_t*)(ws + WS_CONV), DM, 6144);
    else cv_set(j, a.in[30], DM, DM, (bf16_t*)(ws + WS_CONV + 24 * MiB), DM, DM);
}
DI bool cv_advance(CvJob& j, int& id, int& it, int step, const Args& a) {
    it += step;
    while (it >= j.nitems) { it -= j.nitems; ++id; if (id >= CV_NJOBS) return false; cv_job(j, id, a); }
    return true;
}
DI void prologue_phase(unsigned char* lds, const Args& a, const int w0) {
    const int lane = lane_opaque(), wave = w0;
    float* scr = (float*)(lds + wave * 16384);
    const int gw = blockIdx.x * NWAVES + wave, NGW = gridDim.x * NWAVES;
    CvJob jc, jn; int idc = 0, itc = 0;
    cv_job(jc, 0, a);
    bool okc = cv_advance(jc, idc, itc, gw, a);
    f32x4 cur[8], nxt[8];
    if (okc) tr_load(jc.W, jc.Ks, jc.Ns, itc, jc.nblk, lane, cur);
    while (okc) {
        jn = jc; int idn = idc, itn = itc;
        const bool okn = cv_advance(jn, idn, itn, NGW, a);
        if (okn) tr_load(jn.W, jn.Ks, jn.Ns, itn, jn.nblk, lane, nxt);
        tr_finish(jc.WT, jc.Kd, scr, itc, jc.nblk, lane, cur);
#pragma unroll
        for (int i = 0; i < 8; ++i) cur[i] = nxt[i];
        jc = jn; idc = idn; itc = itn; okc = okn;
    }
}

DI void store_pair16(bf16_t* rowbase, int j, int lane, u32x2 w0, u32x2 w1) {
    const bool odd = lane & 1;
    const u32x2 send = odd ? w0 : w1;
    u32x2 recv;
    recv.x = (unsigned)__builtin_amdgcn_update_dpp(0, (int)send.x, 0xB1, 0xF, 0xF, true);
    recv.y = (unsigned)__builtin_amdgcn_update_dpp(0, (int)send.y, 0xB1, 0xF, 0xF, true);
    const u32x4 o = odd ? (u32x4){recv.x, recv.y, w1.x, w1.y} : (u32x4){w0.x, w0.y, recv.x, recv.y};
    *(u32x4*)(rowbase + 256 * (j + (odd ? 1 : 0)) + 8 * (lane >> 1)) = o;
}
DI void load_row(const float* xrow, int lane, f32x4 (&v)[8]) {
#pragma unroll
    for (int j = 0; j < 8; ++j) v[j] = *(const f32x4*)(xrow + j * 256 + lane * 4);
}
DI void finish_row(const float* g, int lane, f32x4 (&v)[8]) {
    float s = 0.f;
#pragma unroll
    for (int j = 0; j < 8; ++j) s += (v[j][0] * v[j][0] + v[j][1] * v[j][1]) + (v[j][2] * v[j][2] + v[j][3] * v[j][3]);
    const float rstd = rsqrtf(wave_sum(s) * (1.0f / DM) + 1e-6f);
#pragma unroll
    for (int j = 0; j < 8; ++j) { const f32x4 gg = *(const f32x4*)(g + j * 256 + lane * 4); v[j] = v[j] * rstd * gg; }
}
DI void finish_row(const LAS float* g, int lane, f32x4 (&v)[8]) {
    float s = 0.f;
#pragma unroll
    for (int j = 0; j < 8; ++j) s += (v[j][0] * v[j][0] + v[j][1] * v[j][1]) + (v[j][2] * v[j][2] + v[j][3] * v[j][3]);
    const float rstd = rsqrtf(wave_sum(s) * (1.0f / DM) + 1e-6f);
#pragma unroll
    for (int j = 0; j < 8; ++j) { const f32x4 gg = *(const LAS f32x4*)(g + j * 256 + lane * 4); v[j] = v[j] * rstd * gg; }
}
DI void norm_row(const float* xrow, const float* g, int lane, f32x4 (&v)[8]) { load_row(xrow, lane, v); finish_row(g, lane, v); }
DI void norm_row(const float* xrow, const LAS float* g, int lane, f32x4 (&v)[8]) { load_row(xrow, lane, v); finish_row(g, lane, v); }

DI void norm_phase(unsigned char* lds, const Ctx& a, const Op& d) {
    const int tid = TID_OF(a), lane = tid & 63, wave = tid >> 6;
    const int gw = a.bid * NWAVES + wave, NGW = a.G * NWAVES;
    if (d.idx == 1 && d.layer == 2) {
        float* scr = (float*)(lds + wave * 16384);
        convert_w(INP(a, 31) + (size_t)d.layer * DM * DFF, DM, DFF, (bf16_t*)(a.ws + WS_MLP), DM, DFF, scr, gw, NGW, lane);
        convert_w(INP(a, 32) + (size_t)d.layer * DM * DFF, DFF, DM, (bf16_t*)(a.ws + WS_MLP + 32 * MiB), DFF, DM, scr, gw, NGW, lane);
    }
    LAS float* g = (LAS float*)(LAS unsigned char*)lds;
    {
        const float* gg = (d.idx == 1 ? INP(a, 2) : INP(a, 1)) + d.layer * DM;
        __syncthreads();
        for (int i = tid * 4; i < DM; i += NTHREADS * 4) *(LAS f32x4*)(g + i) = *(const f32x4*)(gg + i);
        __syncthreads();
    }
    bf16_t* H = (bf16_t*)(a.ws + WS_AR);
    f32x4 nx[8];
    if (gw < MTOK) load_row(d.xin + (size_t)gw * DM, lane, nx);
    for (int m = gw; m < MTOK; m += NGW) {
        f32x4 v[8];
#pragma unroll
        for (int j = 0; j < 8; ++j) v[j] = nx[j];
        if (m + NGW < MTOK) load_row(d.xin + (size_t)(m + NGW) * DM, lane, nx);
        finish_row(g, lane, v);
#pragma unroll
        for (int j = 0; j < 8; j += 2) { u32x2 w0, w1; w0.x = pk2(v[j][0], v[j][1]); w0.y = pk2(v[j][2], v[j][3]); w1.x = pk2(v[j + 1][0], v[j + 1][1]); w1.y = pk2(v[j + 1][2], v[j + 1][3]);
            store_pair16(H + (size_t)m * DM, j, lane, w0, w1); }
    }
}

DI void final_phase(unsigned char* lds, const Ctx& a) {
    const int tid = TID_OF(a), lane = tid & 63, wave = tid >> 6;
    const int gw = a.bid * NWAVES + wave, NGW = a.G * NWAVES;
    LAS float* g = (LAS float*)(LAS unsigned char*)lds;
    { const float* gg = INP(a, 3); for (int i = tid * 4; i < DM; i += NTHREADS * 4) *(LAS f32x4*)(g + i) = *(const f32x4*)(gg + i); __syncthreads(); }
    for (int m = gw; m < MTOK; m += NGW) {
        f32x4 v[8]; norm_row(a.out + (size_t)m * DM, g, lane, v);
#pragma unroll
        for (int j = 0; j < 8; ++j) *(f32x4*)(a.out + (size_t)m * DM + j * 256 + lane * 4) = v[j];
    }
}

DI void mix_phase(unsigned char* lds, const Ctx& a, const Op& d) {
    const int tid = TID_OF(a), lane = tid & 63, wave = tid >> 6;
    const int gw = a.bid * NWAVES + wave, NGW = a.G * NWAVES;
    LAS float* g = (LAS float*)(LAS unsigned char*)lds; LAS float* mu = g + DM;
    {
        const float* gg = INP(a, 1) + d.layer * DM; const float* mg = INP(a, 4) + (size_t)d.idx * 6 * DM;
        for (int i = tid * 4; i < DM; i += NTHREADS * 4) *(LAS f32x4*)(g + i) = *(const f32x4*)(gg + i);
        for (int i = tid * 4; i < 6 * DM; i += NTHREADS * 4) *(LAS f32x4*)(mu + i) = *(const f32x4*)(mg + i);
        __syncthreads();
    }
    unsigned char* AR = a.ws + WS_AR;
    for (int ch = gw; ch < MTOK / 8; ch += NGW) {
        const int m0 = ch * 8;
        f32x4 prev[8], cur[8];
        if ((m0 % SEQ) == 0) {
#pragma unroll
            for (int j = 0; j < 8; ++j) prev[j] = (f32x4){0.f, 0.f, 0.f, 0.f};
        } else norm_row(d.xin + (size_t)(m0 - 1) * DM, g, lane, prev);
        f32x4 nx[8];
        load_row(d.xin + (size_t)m0 * DM, lane, nx);
        for (int r = 0; r < 8; ++r) {
            const int m = m0 + r;
#pragma unroll
            for (int j = 0; j < 8; ++j) cur[j] = nx[j];
            if (r < 7) load_row(d.xin + (size_t)(m + 1) * DM, lane, nx);
            finish_row(g, lane, cur);
#pragma unroll 1
            for (int c = 0; c < 6; ++c) {
                const int slot = (c == 0) ? 0 : (c == 1) ? 3 : (c == 2) ? 1 : (c == 3) ? 2 : (c == 4) ? 4 : 5;
                bf16_t* dst = (bf16_t*)(AR + (size_t)slot * 64 * MiB) + (size_t)m * DM;
#pragma unroll
                for (int j = 0; j < 8; j += 2) {
                    const f32x4 m0_ = *(const LAS f32x4*)(mu + c * DM + j * 256 + lane * 4), m1_ = *(const LAS f32x4*)(mu + c * DM + (j + 1) * 256 + lane * 4);
                    const f32x4 o0 = cur[j] + (prev[j] - cur[j]) * m0_, o1 = cur[j + 1] + (prev[j + 1] - cur[j + 1]) * m1_;
                    u32x2 w0, w1; w0.x = pk2(o0[0], o0[1]); w0.y = pk2(o0[2], o0[3]); w1.x = pk2(o1[0], o1[1]); w1.y = pk2(o1[2], o1[3]);
                    store_pair16(dst, j, lane, w0, w1);
                }
            }
#pragma unroll
            for (int j = 0; j < 8; ++j) prev[j] = cur[j];
        }
    }
}

constexpr int SC_T = 32;
constexpr int SC_BUF = 53248;
DI void scan_phase(unsigned char* lds, const Ctx& a, const Op& d, const int variant) {
    const int tid = TID_OF(a), lane = tid & 63, wave = tid >> 6;
    const int ia = d.idx;
    unsigned char* AR = a.ws + WS_AR;
    const bf16_t *R = (const bf16_t*)(AR + 384 * MiB), *Kb = (const bf16_t*)(AR + 448 * MiB), *Vb = (const bf16_t*)(ia == 0 ? a.ws + WS_VFIRST : AR + 512 * MiB);
    const float* DEC = (const float*)AR; const bf16_t* AG = (const bf16_t*)(AR + 128 * MiB);
    float* Y = (float*)(AR + 256 * MiB);
    const int cgp = tid & 15;
    const int ii = lane >> 4, jg = lane & 15;
    for (int unit = a.bid; unit < NB * 32 * 2; unit += a.G) {
        const int bh = unit >> 1, half = unit & 1, b = bh >> 5, h = bh & 31;
        const int chan = h * 64 + cgp * 4;
        const f32x4 kk4 = *(const f32x4*)(INP(a, 18) + ia * DM + chan), ka4 = *(const f32x4*)(INP(a, 19) + ia * DM + chan);
        const size_t rowbase = (size_t)b * SEQ;
        u32x2 pr, pk, pv, pa; f32x4 pd;
#define SC_LOAD(c, tl, pr, pk, pv, pa, pd) do { const size_t off = (rowbase + (size_t)(c) * SC_T + (tl)) * DM + chan; \
            pr = *(const u32x2*)(R + off); pk = *(const u32x2*)(Kb + off); pv = *(const u32x2*)(Vb + off); pa = *(const u32x2*)(AG + off); pd = *(const f32x4*)(DEC + off); } while (0)
#define SC_STORE(bi, tl, pr, pk, pv, pa, pd) do { float* base = (float*)(lds + (bi) * SC_BUF); \
            const float k0 = bflo(pk.x), k1 = bfhi(pk.x), k2 = bflo(pk.y), k3 = bfhi(pk.y); \
            const float a0 = bflo(pa.x), a1 = bfhi(pa.x), a2 = bflo(pa.y), a3 = bfhi(pa.y); \
            const float r0 = bflo(pr.x), r1 = bfhi(pr.x), r2 = bflo(pr.y), r3 = bfhi(pr.y); \
            float q0 = k0 * kk4[0], q1 = k1 * kk4[1], q2 = k2 * kk4[2], q3 = k3 * kk4[3]; \
            const float n2 = rowsum16((q0 * q0 + q1 * q1) + (q2 * q2 + q3 * q3)); \
            const float inv = 1.0f / fmaxf(sqrtf(n2), 1e-12f); q0 *= inv; q1 *= inv; q2 *= inv; q3 *= inv; \
            const float b0 = q0 * a0, b1 = q1 * a1, b2 = q2 * a2, b3 = q3 * a3; \
            const float e0 = k0 * (1.f + (a0 - 1.f) * ka4[0]), e1 = k1 * (1.f + (a1 - 1.f) * ka4[1]), e2 = k2 * (1.f + (a2 - 1.f) * ka4[2]), e3 = k3 * (1.f + (a3 - 1.f) * ka4[3]); \
            const float br = rowsum16((b0 * r0 + b1 * r1) + (b2 * r2 + b3 * r3)), kr = rowsum16((e0 * r0 + e1 * r1) + (e2 * r2 + e3 * r3)); \
            float* p = base + ((tl) * 16 + cgp) * 20; \
            *(f32x4*)(p) = pd; *(f32x4*)(p + 4) = (f32x4){-q0, -q1, -q2, -q3}; *(f32x4*)(p + 8) = (f32x4){b0, b1, b2, b3}; \
            *(f32x4*)(p + 12) = (f32x4){e0, e1, e2, e3}; *(f32x4*)(p + 16) = (f32x4){pd[0] * r0 - q0 * br, pd[1] * r1 - q1 * br, pd[2] * r2 - q2 * br, pd[3] * r3 - q3 * br}; \
            if ((cgp >> 3) == half) { const float v0 = bflo(pv.x), v1 = bfhi(pv.x), v2 = bflo(pv.y), v3 = bfhi(pv.y); float* vp = base + 10240 + ((tl) * 32 + (cgp & 7) * 4) * 2; \
                *(f32x4*)vp = (f32x4){v0, v0 * kr, v1, v1 * kr}; *(f32x4*)(vp + 4) = (f32x4){v2, v2 * kr, v3, v3 * kr}; } \
            } while (0)
        const bool is_loader = wave >= 4;
        const int ltid = tid & 255, tl0 = ltid >> 4;
        u32x2 pr2, pk2_, pv2, pa2; f32x4 pd2;
        const int rA = (wave & 3) * 8 + 2 * ii;
        f32x2 SA01 = {0.f, 0.f}, SA23 = {0.f, 0.f}, SB01 = {0.f, 0.f}, SB23 = {0.f, 0.f};
#define SC_LOAD2(c) do { SC_LOAD(c, tl0, pr, pk, pv, pa, pd); SC_LOAD(c, tl0 + 16, pr2, pk2_, pv2, pa2, pd2); } while (0)
#define SC_STORE2(bi) do { SC_STORE(bi, tl0, pr, pk, pv, pa, pd); SC_STORE(bi, tl0 + 16, pr2, pk2_, pv2, pa2, pd2); } while (0)
        constexpr int NCH = SEQ / SC_T;
        float* cv_scr = (float*)(lds + 2 * SC_BUF + (wave & 3) * 8448);
        const int cv_total = (ia == 0) ? 32768 : 16384, cv_mask = (ia == 0) ? 3 : 7;
        int cv_item = a.bid * 4 + (wave & 3), cv_pend = -1;
        f32x4 cvr[8];
#define SC_YOUT(c) do { const float* Ys = (const float*)(lds + ((c) & 1) * SC_BUF) + 12288; const int tt = ltid >> 3, e = (ltid & 7) * 4; \
            *(f32x4*)(Y + (rowbase + (size_t)(c) * SC_T + tt) * DM + h * 64 + half * 32 + e) = *(const f32x4*)(Ys + tt * 32 + e); } while (0)
        __syncthreads();
        if (is_loader) { SC_LOAD2(0); SC_STORE2(0); SC_LOAD2(1); }
        __syncthreads();
        for (int c = 0; c < NCH; ++c) {
            const int bi = c & 1;
            float* Yl = (float*)(lds + bi * SC_BUF) + 12288;
            if (is_loader) {
                if ((c & cv_mask) == 0 && cv_item < cv_total) {
                    const int lay = cv_item >> 14, it = cv_item & 16383; const int L = (ia == 0) ? lay : 3;
                    if (it < 8192) tr_load(INP(a, 31) + (size_t)L * DM * DFF, DM, DFF, it, DFF / 32, lane, cvr);
                    else tr_load(INP(a, 32) + (size_t)L * DM * DFF, DFF, DM, it - 8192, DM / 32, lane, cvr);
                    cv_pend = cv_item; cv_item += a.G * 4;
                }
                if ((c & cv_mask) == 2 && cv_pend >= 0) {
                    const int lay = cv_pend >> 14, it = cv_pend & 16383; const int L = (ia == 0) ? lay : 3;
                    bf16_t* WB = (bf16_t*)(a.ws + (L == 1 ? WS_MLP2 : WS_MLP));
                    if (it < 8192) tr_finish(WB, DM, cv_scr, it, DFF / 32, lane, cvr);
                    else tr_finish(WB + (size_t)16 * E_M, DFF, cv_scr, it - 8192, DM / 32, lane, cvr);
                    cv_pend = -1;
                }
                if (c > 0 && !(variant & 4)) SC_YOUT(c - 1);
                if (!(variant & 2)) {
                if (c + 1 < NCH) SC_STORE2(bi ^ 1);
                if (c + 2 < NCH) SC_LOAD2(c + 2);
                }
            } else if (!(variant & 1)) {
                const float* base = (const float*)(lds + bi * SC_BUF);
                const float* rec = base + jg * 20; const float* VVa = base + 10240 + rA * 2;
                f32x4 wA, aA, bA, kA, qA, vA, wB, aB, bB, kB, qB, vB;
#define LO2(x) __builtin_shufflevector(x, x, 0, 1)
#define HI2(x) __builtin_shufflevector(x, x, 2, 3)
#define SC_GET(X, t) do { const float* p = rec + (t) * 320; w##X = *(const f32x4*)p; a##X = *(const f32x4*)(p + 4); b##X = *(const f32x4*)(p + 8); k##X = *(const f32x4*)(p + 12); q##X = *(const f32x4*)(p + 16); \
                v##X = *(const f32x4*)(VVa + (t) * 64); } while (0)
#define SC_STEP(X, t) do { \
                f32x2 pA = SA01 * LO2(a##X); pA = SA23 * HI2(a##X) + pA; f32x2 pB = SB01 * LO2(a##X); pB = SB23 * HI2(a##X) + pB; \
                f32x2 uA = SA01 * LO2(q##X); uA = SA23 * HI2(q##X) + uA; f32x2 uB = SB01 * LO2(q##X); uB = SB23 * HI2(q##X) + uB; \
                float d1 = pA[0] + pA[1], e1 = pB[0] + pB[1], d2 = uA[0] + uA[1], e2 = uB[0] + uB[1]; \
                d1 += dppf<0xB1>(d1); e1 += dppf<0xB1>(e1); d2 += dppf<0xB1>(d2); e2 += dppf<0xB1>(e2); d1 += dppf<0x4E>(d1); e1 += dppf<0x4E>(e1); d2 += dppf<0x4E>(d2); e2 += dppf<0x4E>(e2); \
                d1 += dppf<0x141>(d1); e1 += dppf<0x141>(e1); d2 += dppf<0x141>(d2); e2 += dppf<0x141>(e2); d1 += dppf<0x140>(d1); e1 += dppf<0x140>(e1); d2 += dppf<0x140>(d2); e2 += dppf<0x140>(e2); \
                const f32x2 d1v = {d1, d1}, e1v = {e1, e1}, vav = {v##X[0], v##X[0]}, vbv = {v##X[2], v##X[2]}; \
                SA01 = SA01 * LO2(w##X) + d1v * LO2(b##X) + vav * LO2(k##X); SA23 = SA23 * HI2(w##X) + d1v * HI2(b##X) + vav * HI2(k##X); \
                SB01 = SB01 * LO2(w##X) + e1v * LO2(b##X) + vbv * LO2(k##X); SB23 = SB23 * HI2(w##X) + e1v * HI2(b##X) + vbv * HI2(k##X); \
                if (jg == 0) *(f32x2*)(Yl + (t) * 32 + rA) = (f32x2){d2 + v##X[1], e2 + v##X[3]}; } while (0)
                SC_GET(A, 0);
#pragma unroll 2
                for (int t = 0; t < SC_T; t += 2) {
                    SC_GET(B, t + 1);
                    SC_STEP(A, t);
                    if (t + 2 < SC_T) SC_GET(A, t + 2);
                    SC_STEP(B, t + 1);
                }
#undef LO2
#undef HI2
#undef SC_GET
#undef SC_STEP
            }
            __syncthreads();
        }
        if (is_loader && !(variant & 4)) SC_YOUT(NCH - 1);
        if (is_loader) {
            for (;;) {
                if (cv_pend < 0) { if (cv_item >= cv_total) break;
                    const int lay = cv_item >> 14, it = cv_item & 16383; const int L = (ia == 0) ? lay : 3;
                    if (it < 8192) tr_load(INP(a, 31) + (size_t)L * DM * DFF, DM, DFF, it, DFF / 32, lane, cvr);
                    else tr_load(INP(a, 32) + (size_t)L * DM * DFF, DFF, DM, it - 8192, DM / 32, lane, cvr);
                    cv_pend = cv_item; cv_item += a.G * 4; }
                const int lay = cv_pend >> 14, it = cv_pend & 16383; const int L = (ia == 0) ? lay : 3;
                bf16_t* WB = (bf16_t*)(a.ws + (L == 1 ? WS_MLP2 : WS_MLP));
                if (it < 8192) tr_finish(WB, DM, cv_scr, it, DFF / 32, lane, cvr);
                else tr_finish(WB + (size_t)16 * E_M, DFF, cv_scr, it - 8192, DM / 32, lane, cvr);
                cv_pend = -1;
            }
        }
#undef SC_YOUT
#undef SC_LOAD2
#undef SC_STORE2
#undef SC_LOAD
#undef SC_STORE
    }
}

DI void gngate_phase(unsigned char* lds, const Ctx& a, const Op& d) {
    const int ia = d.idx;
    unsigned char* AR = a.ws + WS_AR;
    const bf16_t *R = (const bf16_t*)(AR + 384 * MiB), *Kb = (const bf16_t*)(AR + 448 * MiB), *Vb = (const bf16_t*)(ia == 0 ? a.ws + WS_VFIRST : AR + 512 * MiB);
    const bf16_t* AG = (const bf16_t*)(AR + 128 * MiB); const bf16_t* G = (const bf16_t*)(AR + 192 * MiB);
    const float* Y = (const float*)(AR + 256 * MiB);
    bf16_t* YG = (bf16_t*)(AR + 608 * MiB);
    LAS float* pl = (LAS float*)(LAS unsigned char*)lds;
    {
        const int t_ = TID_OF(a);
        const float *s0 = INP(a, 19) + ia * DM, *s1 = INP(a, 20) + ia * DM, *s2 = INP(a, 21) + ia * DM, *s3 = INP(a, 22) + ia * DM;
        for (int i = t_ * 4; i < DM; i += NTHREADS * 4) { *(LAS f32x4*)(pl + i) = *(const f32x4*)(s0 + i); *(LAS f32x4*)(pl + DM + i) = *(const f32x4*)(s1 + i);
            *(LAS f32x4*)(pl + 2 * DM + i) = *(const f32x4*)(s2 + i); *(LAS f32x4*)(pl + 3 * DM + i) = *(const f32x4*)(s3 + i); }
        __syncthreads();
    }
    const LAS float *k_a = pl, *r_k = pl + DM, *lw = pl + 2 * DM, *lb = pl + 3 * DM;
    const size_t total = (size_t)MTOK * DM / 8, stride = (size_t)a.G * NTHREADS;
#pragma unroll 2
    for (size_t it = (size_t)a.bid * NTHREADS + TID_OF(a); it < total; it += stride) {
        const size_t off = it * 8; const int col = (int)(off % DM);
        const f32x4 y0 = *(const f32x4*)(Y + off), y1 = *(const f32x4*)(Y + off + 4);
        const u32x4 ur = *(const u32x4*)(R + off), uk = *(const u32x4*)(Kb + off), uv = *(const u32x4*)(Vb + off), ua = *(const u32x4*)(AG + off), ug = *(const u32x4*)(G + off);
        float ys = ((y0[0] + y0[1]) + (y0[2] + y0[3])) + ((y1[0] + y1[1]) + (y1[2] + y1[3]));
        ys += dppf<0xB1>(ys); ys += dppf<0x4E>(ys); ys += dppf<0x141>(ys);
        const float mean = ys * (1.0f / 64.0f);
        const f32x4 d0 = y0 - mean, d1 = y1 - mean;
        float vs = ((d0[0] * d0[0] + d0[1] * d0[1]) + (d0[2] * d0[2] + d0[3] * d0[3])) + ((d1[0] * d1[0] + d1[1] * d1[1]) + (d1[2] * d1[2] + d1[3] * d1[3]));
        vs += dppf<0xB1>(vs); vs += dppf<0x4E>(vs); vs += dppf<0x141>(vs);
        const float rs = rsqrtf(vs * (1.0f / 64.0f) + 64e-5f);
        float rr[8], kk[8], vv[8], gg[8], dy[8];
        float bs = 0.f;
#pragma unroll
        for (int q = 0; q < 4; ++q) {
            rr[2 * q] = bflo(ur[q]); rr[2 * q + 1] = bfhi(ur[q]); vv[2 * q] = bflo(uv[q]); vv[2 * q + 1] = bfhi(uv[q]); gg[2 * q] = bflo(ug[q]); gg[2 * q + 1] = bfhi(ug[q]);
            const float a0 = bflo(ua[q]), a1 = bfhi(ua[q]);
            const float ka0 = k_a[col + 2 * q], ka1 = k_a[col + 2 * q + 1];
            kk[2 * q] = bflo(uk[q]) * (1.f + (a0 - 1.f) * ka0); kk[2 * q + 1] = bfhi(uk[q]) * (1.f + (a1 - 1.f) * ka1);
            bs += rr[2 * q] * kk[2 * q] * r_k[col + 2 * q] + rr[2 * q + 1] * kk[2 * q + 1] * r_k[col + 2 * q + 1];
        }
        bs += dppf<0xB1>(bs); bs += dppf<0x4E>(bs); bs += dppf<0x141>(bs);
#pragma unroll
        for (int q = 0; q < 4; ++q) { dy[q] = d0[q]; dy[4 + q] = d1[q]; }
        u32x4 w;
#pragma unroll
        for (int q = 0; q < 4; ++q) {
            const float o0 = (dy[2 * q] * rs * lw[col + 2 * q] + lb[col + 2 * q] + bs * vv[2 * q]) * gg[2 * q];
            const float o1 = (dy[2 * q + 1] * rs * lw[col + 2 * q + 1] + lb[col + 2 * q + 1] + bs * vv[2 * q + 1]) * gg[2 * q + 1];
            w[q] = pk2(o0, o1);
        }
        *(u32x4*)(YG + off) = w;
    }
}

DI void convgate_phase(const Ctx& a, const Op& d) {
    unsigned char* AR = a.ws + WS_AR;
    const bf16_t* BCH = (const bf16_t*)(AR + 64 * MiB); bf16_t* Z = (bf16_t*)(AR + 256 * MiB);
    const float* cw = INP(a, 29);
    constexpr int RUN = 16;
    const int total = (MTOK / RUN) * (DM / 8), stride = a.G * NTHREADS;
    for (int it = a.bid * NTHREADS + TID_OF(a); it < total; it += stride) {
        const int rn = it / (DM / 8), c0 = (it % (DM / 8)) * 8, t0 = rn * RUN;
        float w0[8], w1[8], w2[8], um2[8], um1[8];
#pragma unroll
        for (int e = 0; e < 8; ++e) { w0[e] = cw[c0 + e]; w1[e] = cw[DM + c0 + e]; w2[e] = cw[2 * DM + c0 + e]; um2[e] = 0.f; um1[e] = 0.f; }
        if ((t0 % SEQ) != 0) {
#pragma unroll
            for (int q = 0; q < 2; ++q) {
                const bf16_t* row = BCH + (size_t)(t0 - 2 + q) * 6144;
                const u32x4 c4 = *(const u32x4*)(row + DM + c0), h4 = *(const u32x4*)(row + 2 * DM + c0);
#pragma unroll
                for (int e = 0; e < 4; ++e) { const float u0 = bflo(c4[e]) * bflo(h4[e]), u1 = bfhi(c4[e]) * bfhi(h4[e]);
                    if (q == 0) { um2[2 * e] = u0; um2[2 * e + 1] = u1; } else { um1[2 * e] = u0; um1[2 * e + 1] = u1; } }
            }
        }
        for (int t = t0; t < t0 + RUN; ++t) {
            const bf16_t* row = BCH + (size_t)t * 6144;
            const u32x4 b4 = *(const u32x4*)(row + c0), c4 = *(const u32x4*)(row + DM + c0), h4 = *(const u32x4*)(row + 2 * DM + c0);
            u32x4 o;
#pragma unroll
            for (int e = 0; e < 4; ++e) {
                const float u0 = bflo(c4[e]) * bflo(h4[e]), u1 = bfhi(c4[e]) * bfhi(h4[e]);
                const float z0 = bflo(b4[e]) * (w0[2 * e] * um2[2 * e] + w1[2 * e] * um1[2 * e] + w2[2 * e] * u0);
                const float z1 = bfhi(b4[e]) * (w0[2 * e + 1] * um2[2 * e + 1] + w1[2 * e + 1] * um1[2 * e + 1] + w2[2 * e + 1] * u1);
                um2[2 * e] = um1[2 * e]; um2[2 * e + 1] = um1[2 * e + 1]; um1[2 * e] = u0; um1[2 * e + 1] = u1;
                o[e] = pk2(z0, z1);
            }
            *(u32x4*)(Z + (size_t)t * DM + c0) = o;
        }
    }
}

constexpr int AT_KP = 72, AT_VP = 264;
DI void attn_phase(unsigned char* lds, const Ctx& a, const Op& d, const int variant) {
    const int tid = TID_OF(a), lane = tid & 63, wave = tid >> 6;
    unsigned char* AR = a.ws + WS_AR;
    const bf16_t* QKV = (const bf16_t*)(AR + 64 * MiB); bf16_t* O = (bf16_t*)(AR + 144 * MiB);
    bf16_t* Ks = (bf16_t*)lds; bf16_t* Vt = (bf16_t*)(lds + 256 * AT_KP * 2);
    const int l32 = lane & 31, hh = lane >> 5;
    for (int unit = a.bid; unit < NB * 32 * 4; unit += a.G) {
        const int kvh = unit & 3, nb = (unit >> 2) & 31, b = unit >> 7;
        const size_t row0 = (size_t)b * SEQ + (size_t)nb * 128 - 128;
        bf16x8 qall[4][4];
        {
            const int qh_ = kvh * 8 + wave;
#pragma unroll
            for (int qc = 0; qc < 4; ++qc) {
                const size_t qrow_ = (size_t)b * SEQ + (size_t)nb * 128 + qc * 32 + l32;
#pragma unroll
                for (int ks = 0; ks < 4; ++ks) qall[qc][ks] = *(const bf16x8*)(QKV + qrow_ * 2560 + qh_ * 64 + ks * 16 + hh * 8);
            }
        }
        __syncthreads();
        if (!(variant & 2))
#pragma unroll
        for (int i = 0; i < 4; ++i) {
            const int chunk = tid + i * NTHREADS, key = chunk >> 3, dc = (chunk & 7) * 8;
            u32x4 kv = (u32x4){0u, 0u, 0u, 0u}, vv = (u32x4){0u, 0u, 0u, 0u};
            if (nb > 0 || key >= 128) { const bf16_t* rp = QKV + (row0 + key) * 2560 + 2048 + kvh * 64 + dc; kv = *(const u32x4*)rp; vv = *(const u32x4*)(rp + 256); }
            *(u32x4*)(Ks + key * AT_KP + dc) = kv;
#pragma unroll
            for (int e = 0; e < 4; ++e) { Vt[(dc + 2 * e) * AT_VP + key] = (bf16_t)(vv[e] & 0xffffu); Vt[(dc + 2 * e + 1) * AT_VP + key] = (bf16_t)(vv[e] >> 16); }
        }
        __syncthreads();
        const int qh = kvh * 8 + wave;
        const float sink = INP(a, 27)[qh];
        if (!(variant & 1))
#pragma unroll
        for (int qc = 0; qc < 4; ++qc) {
            const size_t qrow = (size_t)b * SEQ + (size_t)nb * 128 + qc * 32 + l32;
            bf16x8 qf[4];
#pragma unroll
            for (int ks = 0; ks < 4; ++ks) qf[ks] = qall[qc][ks];
            f32x16 s[5];
#pragma unroll
            for (int kb = 0; kb < 5; ++kb) {
#pragma unroll
                for (int i = 0; i < 16; ++i) s[kb][i] = 0.f;
                const int kbi = qc + kb;
#pragma unroll
                for (int ks = 0; ks < 4; ++ks) {
                    const bf16x8 kf = *(const bf16x8*)(Ks + (kbi * 32 + l32) * AT_KP + ks * 16 + hh * 8);
                    s[kb] = __builtin_amdgcn_mfma_f32_32x32x16_bf16(kf, qf[ks], s[kb], 0, 0, 0);
                }
            }
            const int qi = qc * 32 + l32;
            float mx = -INFINITY;
#pragma unroll
            for (int kb = 0; kb < 5; ++kb)
#pragma unroll
                for (int i = 0; i < 16; ++i) {
                    const int key = (qc + kb) * 32 + (i >> 2) * 8 + hh * 4 + (i & 3);
                    const int rel = 128 + qi - key;
                    const bool ok = (rel >= 0) && (rel < 128) && (nb > 0 || key >= 128);
                    s[kb][i] = ok ? s[kb][i] : -INFINITY;
                    mx = fmaxf(mx, s[kb][i]);
                }
            mx = fmaxf(mx, xor32(mx, lane));
            mx = fmaxf(mx, sink);
            float sum = 0.f;
#pragma unroll
            for (int kb = 0; kb < 5; ++kb)
#pragma unroll
                for (int i = 0; i < 16; ++i) { const float p = __expf(s[kb][i] - mx); s[kb][i] = p; sum += p; }
            sum += xor32(sum, lane);
            const float inv = 1.0f / (sum + __expf(sink - mx));
            f32x16 o[2];
#pragma unroll
            for (int db = 0; db < 2; ++db)
#pragma unroll
                for (int i = 0; i < 16; ++i) o[db][i] = 0.f;
#pragma unroll
            for (int kb = 0; kb < 5; ++kb)
#pragma unroll
                for (int st = 0; st < 2; ++st) {
                    u32x4 pw;
                    pw.x = pk2(s[kb][8 * st + 0], s[kb][8 * st + 1]); pw.y = pk2(s[kb][8 * st + 2], s[kb][8 * st + 3]);
                    pw.z = pk2(s[kb][8 * st + 4], s[kb][8 * st + 5]); pw.w = pk2(s[kb][8 * st + 6], s[kb][8 * st + 7]);
                    const bf16x8 pf = __builtin_bit_cast(bf16x8, pw);
                    const int key0 = (qc + kb) * 32 + (2 * st) * 8 + hh * 4;
#pragma unroll
                    for (int db = 0; db < 2; ++db) {
                        const bf16_t* vp = Vt + (db * 32 + l32) * AT_VP + key0;
                        const u32x2 v0 = *(const u32x2*)vp, v1 = *(const u32x2*)(vp + 8);
                        const u32x4 vw = (u32x4){v0.x, v0.y, v1.x, v1.y};
                        o[db] = __builtin_amdgcn_mfma_f32_32x32x16_bf16(__builtin_bit_cast(bf16x8, vw), pf, o[db], 0, 0, 0);
                    }
                }
            bf16_t* orow = O + qrow * DM + qh * 64;
#pragma unroll
            for (int db = 0; db < 2; ++db)
#pragma unroll
                for (int g4 = 0; g4 < 4; ++g4) {
                    u32x2 w; w.x = pk2(o[db][4 * g4] * inv, o[db][4 * g4 + 1] * inv); w.y = pk2(o[db][4 * g4 + 2] * inv, o[db][4 * g4 + 3] * inv);
                    *(u32x2*)(orow + db * 32 + g4 * 8 + hh * 4) = w;
                }
        }
    }
}

#define XB_TMO      128
#define XB_XCNT(j)  (256  + 64 * (j))
#define XB_XSUB(j)  (1280 + 64 * (j))
#define XB_XGEN(j)  (2304 + 64 * (j))
#define XB_TOP      3328
#define XB_TOPGEN   3392
#define XCD_BAR_WORDS 3456
#define XB_SPIN_CAP (1u << 18)

__device__ __forceinline__ unsigned xb_ld(unsigned* p)              { return __hip_atomic_load(p, __ATOMIC_RELAXED, __HIP_MEMORY_SCOPE_AGENT); }
__device__ __forceinline__ unsigned xb_add(unsigned* p, unsigned v) { return __hip_atomic_fetch_add(p, v, __ATOMIC_RELAXED, __HIP_MEMORY_SCOPE_AGENT); }
__device__ __forceinline__ unsigned xb_xcc_id() { return (unsigned)__builtin_amdgcn_s_getreg((3 << 11) | 20) & 0xFu; }
#define XB_SPIN(cond, bar) do { unsigned _sp = 0; while (cond) { __builtin_amdgcn_s_sleep(1); \
    if ((++_sp & 255u) == 0u) { if (xb_ld(&(bar)[XB_TMO])) break; if (_sp > XB_SPIN_CAP) { atomicAdd(&(bar)[XB_TMO], 1u); break; } } } } while (0)

struct XcdBarrier {
    unsigned* bar; unsigned x;
    volatile LAS unsigned* st;
};

__device__ __forceinline__ XcdBarrier xcd_barrier_post(unsigned* bar, volatile LAS unsigned* st) {
    XcdBarrier b; b.bar = bar; b.x = xb_xcc_id(); b.st = st;
    if (threadIdx.x == 0) (void)xb_add(&bar[XB_XCNT(b.x)], 1u);
    return b;
}
__device__ __forceinline__ void xcd_barrier_complete(unsigned* bar, unsigned x, unsigned& nloc, unsigned& nx) {
    const unsigned G = gridDim.x * gridDim.y * gridDim.z;
    unsigned sum, cnt, mine, sp = 0u;
    for (;;) {
        sum = 0u; cnt = 0u; mine = 0u;
#pragma unroll
        for (unsigned j = 0; j < 16; ++j) { const unsigned c = xb_ld(&bar[XB_XCNT(j)]); sum += c; cnt += (c > 0u) ? 1u : 0u; mine = (j == x) ? c : mine; }
        if (sum == G) break;
        __builtin_amdgcn_s_sleep(1);
        if ((++sp & 255u) == 0u) { if (xb_ld(&bar[XB_TMO])) break; if (sp > XB_SPIN_CAP) { atomicAdd(&bar[XB_TMO], 1u); break; } }
    }
    nloc = mine > 0u ? mine : 1u; nx = cnt > 0u ? cnt : 1u;
}

__device__ __forceinline__ void xcd_barrier(const XcdBarrier& b) {
    asm volatile("s_waitcnt vmcnt(0)" ::: "memory");
    __syncthreads();
    if (threadIdx.x == 0) {
        unsigned* bar = b.bar;
        __builtin_amdgcn_s_waitcnt(0);
        unsigned nloc = b.st[0], nx = b.st[1];
        if (nloc == 0u) { xcd_barrier_complete(bar, b.x, nloc, nx); b.st[0] = nloc; b.st[1] = nx; }
        const unsigned old = xb_add(&bar[XB_XSUB(b.x)], 1u);
        const unsigned gen = old / nloc;
        if (old + 1u == (gen + 1u) * nloc) {
            __builtin_amdgcn_fence(__ATOMIC_RELEASE, "agent");
            asm volatile("s_waitcnt vmcnt(0)" ::: "memory");
            const unsigned og = xb_add(&bar[XB_TOP], 1u);
            const unsigned tg = og / nx;
            if (og + 1u == (tg + 1u) * nx) xb_add(&bar[XB_TOPGEN], 1u);
            else XB_SPIN(xb_ld(&bar[XB_TOPGEN]) == tg, bar);
            __builtin_amdgcn_fence(__ATOMIC_ACQUIRE, "agent");
            xb_add(&bar[XB_XGEN(b.x)], 1u);
            asm volatile("s_waitcnt vmcnt(0)" ::: "memory");
        } else {
            XB_SPIN(xb_ld(&bar[XB_XGEN(b.x)]) == gen, bar);
            __builtin_amdgcn_fence(__ATOMIC_ACQUIRE, "agent");
            asm volatile("s_waitcnt vmcnt(0)" ::: "memory");
        }
    }
    __syncthreads();
}


constexpr size_t WS_BAR = 65536, BAR_BYTES = 16384;
constexpr int MISC_OFF = LDS_BYTES - 64;
__global__ void __launch_bounds__(NTHREADS, 2) fwd_megakernel(Args a) {
    extern __shared__ __attribute__((aligned(16))) unsigned char lds[];
    cg::grid_group grid = cg::this_grid();
    const int w0 = __builtin_amdgcn_readfirstlane(threadIdx.x >> 6);
    volatile LAS unsigned* bst = (volatile LAS unsigned*)((LAS unsigned char*)lds + MISC_OFF);
    if (threadIdx.x < 2) bst[threadIdx.x] = 0u;
    __syncthreads();
    XcdBarrier xbar = xcd_barrier_post((unsigned*)(a.ws + WS_BAR), bst);
    if (blockIdx.x == 0 && threadIdx.x == 0) {
        const float** tbl = (const float**)a.ws;
#pragma unroll
        for (int i = 0; i < 33; ++i) tbl[i] = a.in[i];
    }
    if (blockIdx.x == 0 && threadIdx.x == 64) {
        Op* tab = (Op*)(a.ws + WS_OPTAB);
        for (int op = 0; op < NOPS_TOTAL; ++op) { Op d; build_op(d, op, a); d.pad_[0] = 0; d.pad_[1] = 0; d.pad_[2] = 0; d.pad_[3] = 0; tab[op] = d; }
    }
    if (a.op_lo == 0) prologue_phase(lds, a, w0);
    if (a.op_hi < 0) grid.sync();
    xcd_barrier(xbar);
    for (int op = (a.op_lo == 0 ? 1 : a.op_lo); op < a.op_hi; ++op) {
        Ctx c;
        {
            unsigned long long po = (unsigned long long)a.out, pw = (unsigned long long)a.ws; int b_ = blockIdx.x, g_ = gridDim.x, w_ = w0;
            asm volatile("" : "+s"(po), "+s"(pw), "+s"(b_), "+s"(g_), "+s"(w_));
            const unsigned long long pol = (unsigned)__builtin_amdgcn_readfirstlane((int)(unsigned)po), poh = (unsigned)__builtin_amdgcn_readfirstlane((int)(unsigned)(po >> 32));
            const unsigned long long pwl = (unsigned)__builtin_amdgcn_readfirstlane((int)(unsigned)pw), pwh = (unsigned)__builtin_amdgcn_readfirstlane((int)(unsigned)(pw >> 32));
            c.out = (float*)(pol | (poh << 32)); c.ws = (unsigned char*)(pwl | (pwh << 32));
            c.bid = __builtin_amdgcn_readfirstlane(b_); c.G = __builtin_amdgcn_readfirstlane(g_); c.w0 = __builtin_amdgcn_readfirstlane(w_);
        }
        Op d;
        {
            const unsigned* p = (const unsigned*)(c.ws + WS_OPTAB) + (size_t)__builtin_amdgcn_readfirstlane(op) * 32;
            unsigned w[32];
#pragma unroll
            for (int i = 0; i < 32; ++i) w[i] = (unsigned)__builtin_amdgcn_readfirstlane((int)p[i]);
            __builtin_memcpy(&d, w, 128);
        }
#ifndef REP_MASK
#define REP_MASK 0
#endif
#ifndef SCAN_VARIANT
#define SCAN_VARIANT 0
#endif
#ifndef SYNC_REP
#define SYNC_REP 1
#endif
        const bool idem = (d.kind != K_GEMM) || (d.emode == pg8::EM_BF16 || d.emode == pg8::EM_DECAY) || (d.emode == pg8::EM_RESID && ((REP_MASK >> 9) & 1));
        const int reps = (((REP_MASK >> d.kind) & 1) && idem && d.kind != K_FINAL) ? 2 : 1;
        for (int rep = 0; rep < reps; ++rep) {
        if (rep) __syncthreads();
#ifndef NO_GEMM
        if (d.kind == K_GEMM) {
            pg8::Gemm g{d.A, d.Bt, d.lda, d.ldb, d.N, d.K};
            pg8::StaticOrder S; S.init(MTOK, d.N, c.G, (c.bid + c.G - d.shift) % c.G);
            pg8::Epi E{d.emode, d.act, d.out, d.ldc, d.bias, d.p1, d.qcols, rep};
            pg8::gemm_phase<pg8::StaticOrder>((LAS unsigned char*)lds, g, S, E, c.w0);
        } else
#endif
#ifndef NO_MIX
        if (d.kind == K_MIX) mix_phase(lds, c, d); else
#endif
#ifndef NO_NORM
        if (d.kind == K_NORM) norm_phase(lds, c, d); else
#endif
#ifndef NO_SCAN
        if (d.kind == K_SCAN) scan_phase(lds, c, d, rep ? SCAN_VARIANT : 0); else
#endif
#ifndef NO_GN
        if (d.kind == K_GNGATE) gngate_phase(lds, c, d); else
#endif
#ifndef NO_ATTN
        if (d.kind == K_ATTN) attn_phase(lds, c, d, rep ? SCAN_VARIANT : 0); else
#endif
#ifndef NO_CONV
        if (d.kind == K_CONVGATE) convgate_phase(c, d); else
#endif
        final_phase(lds, c);
        }
        if (d.sync && op + 1 < a.op_hi) { for (int r = 0; r < SYNC_REP; ++r) xcd_barrier(xbar); } else __syncthreads();
    }
}

extern "C" void kernel_launch(void* const* d_in, const int* in_sizes, int n_in, void* d_out, int out_size, void* d_ws, size_t ws_size, hipStream_t stream) {
    static int grid_blocks = 0;
    if (!grid_blocks) {
        if (n_in != 33 || out_size != MTOK * DM || ws_size < WS_NEED) { fprintf(stderr, "kernel_launch: unexpected problem (n_in %d out %d ws %zu)\n", n_in, out_size, ws_size); grid_blocks = -1; return; }
        int dev = 0, cus = 0, per_cu = 0;
        (void)hipGetDevice(&dev);
        (void)hipDeviceGetAttribute(&cus, hipDeviceAttributeMultiprocessorCount, dev);
        (void)hipFuncSetAttribute((const void*)fwd_megakernel, hipFuncAttributeMaxDynamicSharedMemorySize, LDS_BYTES);
        (void)hipOccupancyMaxActiveBlocksPerMultiprocessor(&per_cu, (const void*)fwd_megakernel, NTHREADS, LDS_BYTES);
        if (per_cu < 1) per_cu = 1;
        grid_blocks = cus * per_cu;
        (void)hipGetLastError();
    }
    if (grid_blocks < 0) return;
    Args a{};
    for (int i = 0; i < 33; ++i) a.in[i] = (const float*)d_in[i];
    a.out = (float*)d_out; a.ws = (unsigned char*)d_ws; a.op_lo = 0; a.op_hi = NOPS_TOTAL;
    (void)hipMemsetAsync((char*)d_ws + WS_BAR, 0, BAR_BYTES, stream);
    void* args[] = {&a};
    hipError_t e = hipLaunchCooperativeKernel((const void*)fwd_megakernel, dim3(grid_blocks), dim3(NTHREADS), args, LDS_BYTES, stream);
    if (e != hipSuccess) fprintf(stderr, "cooperative launch failed: %s (grid %d)\n", hipGetErrorString(e), grid_blocks);
}
```

```cpp
#include <hip/hip_runtime.h>
#include <hip/hip_cooperative_groups.h>
#include <cstdio>
#include <cstdint>
namespace cg = cooperative_groups;

#define LAS __attribute__((address_space(3)))
#define DI __device__ __forceinline__
typedef unsigned short bf16_t;
typedef short bf16x8 __attribute__((ext_vector_type(8)));
typedef float f32x4 __attribute__((ext_vector_type(4)));
typedef float f32x2 __attribute__((ext_vector_type(2)));
typedef float f32x16 __attribute__((ext_vector_type(16)));
typedef unsigned u32x4 __attribute__((ext_vector_type(4)));
typedef unsigned u32x2 __attribute__((ext_vector_type(2)));

constexpr int DM = 2048, NB = 4, SEQ = 4096, MTOK = NB * SEQ, DFF = 8192, DEPTH = 4;
constexpr int NTHREADS = 512, NWAVES = 8;
constexpr int LDS_BYTES = 147456;
constexpr size_t MiB = (size_t)1 << 20;
constexpr size_t WS_RW0 = 1 * MiB, WS_RW1 = 41 * MiB, WS_SWA = 81 * MiB, WS_CONV = 99 * MiB, WS_MLP = 131 * MiB, WS_VFIRST = 195 * MiB, WS_AR = 259 * MiB;
constexpr size_t WS_NEED = 1008 * MiB;
constexpr size_t WS_MLP2 = 944 * MiB;
constexpr size_t E_M = (size_t)1 << 20;
constexpr size_t RW_WR = 0, RW_WK = 4 * E_M, RW_WV = 8 * E_M, RW_L1 = 12 * E_M, RW_W2 = 14 * E_M, RW_A2 = 14 * E_M + 256 * 1024, RW_G2 = 14 * E_M + 512 * 1024,
                 RW_V2 = 15 * E_M, RW_WO = 15 * E_M + 256 * 1024;

DI unsigned f2bf(float f) { unsigned u = __builtin_bit_cast(unsigned, f); return (u + 0x7fffu + ((u >> 16) & 1u)) >> 16; }
DI unsigned pk2(float lo, float hi) { unsigned r; asm volatile("v_cvt_pk_bf16_f32 %0, %1, %2" : "=v"(r) : "v"(lo), "v"(hi)); return r; }
DI float bflo(unsigned u) { return __builtin_bit_cast(float, u << 16); }
DI float bfhi(unsigned u) { return __builtin_bit_cast(float, u & 0xffff0000u); }
DI float sigmoidf_(float x) { return 1.0f / (1.0f + __expf(-x)); }
DI int lane_opaque() { int l; asm volatile("v_mbcnt_lo_u32_b32 %0, -1, 0\n\tv_mbcnt_hi_u32_b32 %0, -1, %0" : "=v"(l)); return l; }
#define TID_OF(a) ((a).w0 * 64 + lane_opaque())
template <int CTRL> DI float dppf(float v) { return __builtin_bit_cast(float, __builtin_amdgcn_update_dpp(0, __builtin_bit_cast(int, v), CTRL, 0xF, 0xF, true)); }
DI float rowsum16(float v) { v += dppf<0xB1>(v); v += dppf<0x4E>(v); v += dppf<0x141>(v); v += dppf<0x140>(v); return v; }
DI float wave_sum(float v) {
    v = rowsum16(v);
    const int u = __builtin_bit_cast(int, v);
    return (__builtin_bit_cast(float, __builtin_amdgcn_readlane(u, 0)) + __builtin_bit_cast(float, __builtin_amdgcn_readlane(u, 16))) +
           (__builtin_bit_cast(float, __builtin_amdgcn_readlane(u, 32)) + __builtin_bit_cast(float, __builtin_amdgcn_readlane(u, 48)));
}
DI float xor32(float v, int lane) { return __builtin_bit_cast(float, __builtin_amdgcn_ds_bpermute((lane ^ 32) << 2, __builtin_bit_cast(int, v))); }

namespace pg8 {
constexpr int BM = 256, BK = 64, HALF = 128, HTB = HALF * BK * 2, STAGE_BYTES = 8 * HTB, NXCD = 8, WGM = 8;
__host__ __device__ __forceinline__ int lds_byte(int r, int c) { const int st = (r >> 4) * 2 + (c >> 5), rr = r & 15, cc = c & 31, ob = rr * 64 + cc * 2; return st * 1024 + (ob ^ (((ob >> 9) & 1) << 5)); }
__host__ __device__ __forceinline__ void stage_rc(int b, int& R, int& C) { const int st = b / 1024, sb = b % 1024, swz = sb ^ (((sb >> 9) & 1) << 5); R = (st >> 1) * 16 + swz / 64; C = (st & 1) * 32 + (swz % 64) / 2; }
__host__ __device__ __forceinline__ int perm32(int rho) { const int n = rho >> 4, i = rho & 15; return 8 * (i >> 2) + 4 * n + (i & 3); }

struct Unit { int pm, pn; };
struct Gemm { const bf16_t* A; const bf16_t* Bt; int lda, ldb, N, K; };

struct StaticOrder {
    int nM, nN, nwg, G, c;
    DI void init(int M, int N, int G_, int c_) { nM = M / BM; nN = N / BM; nwg = nM * nN; G = G_; c = c_; }
    DI bool next(int i, Unit& u) const {
        const long L = (long)i * G + c; if (L >= nwg) return false;
        int wgid = (int)L; { const int q = nwg / NXCD, r = nwg % NXCD, xcd = wgid % NXCD, off = wgid / NXCD; wgid = (xcd < r ? xcd * (q + 1) : r * (q + 1) + (xcd - r) * q) + off; }
        const int nig = WGM * nN, gid = wgid / nig, fm = gid * WGM, gsz = (nM - fm) < WGM ? (nM - fm) : WGM;
        u.pm = fm + ((wgid % nig) % gsz); u.pn = (wgid % nig) / gsz; return true;
    }
};

enum { EM_BF16 = 0, EM_VMIX = 1, EM_RESID = 2, EM_DECAY = 3 };
enum { ACT_NONE = 0, ACT_RELU2 = 1, ACT_TANH = 2, ACT_SIGMOID = 3 };
struct Epi {
    int mode, act; void* out; int ldc; const float* bias; const void* p1; int qcols; int dry;
    DI bool perm() const { return mode == EM_BF16 || mode == EM_VMIX; }
    DI float actf(float v) const {
        if (act == ACT_RELU2) { v = v > 0.f ? v : 0.f; return v * v; }
        if (act == ACT_TANH) { const float e = __expf(2.f * v); return 1.f - 2.f / (e + 1.f); }
        if (act == ACT_SIGMOID) return sigmoidf_(v);
        return v;
    }
    template <int ACT> static DI float act_c(float v) {
        if (ACT == ACT_RELU2) { v = v > 0.f ? v : 0.f; return v * v; }
        if (ACT == ACT_TANH) { const float e = __expf(2.f * v); return 1.f - 2.f / (e + 1.f); }
        if (ACT == ACT_SIGMOID) return sigmoidf_(v);
        return v;
    }
    template <int ACT  > DI void perm_body(const f32x4 (&acc)[2][2][4][2], const f32x4 (&bv)[2][2], const int row0, const int col0) const {
#pragma unroll
        for (int ai = 0; ai < 2; ++ai)
#pragma unroll
            for (int m = 0; m < 4; ++m) {
                const size_t roff = (size_t)(row0 + ai * HALF + m * 16) * ldc + col0;
#pragma unroll
                for (int bj = 0; bj < 2; ++bj) {
                    const f32x4 v0 = acc[ai][bj][m][0] + bv[bj][0], v1 = acc[ai][bj][m][1] + bv[bj][1];
                    bf16_t* op = (bf16_t*)out + roff + bj * HALF;
                    u32x4 w;
                    if (ACT == -1) {
                        const u32x4 vc = *(const u32x4*)op, vf = *(const u32x4*)((const bf16_t*)p1 + roff + bj * HALF);
                        const float g[8] = {sigmoidf_(v0[0]), sigmoidf_(v0[1]), sigmoidf_(v0[2]), sigmoidf_(v0[3]), sigmoidf_(v1[0]), sigmoidf_(v1[1]), sigmoidf_(v1[2]), sigmoidf_(v1[3])};
#pragma unroll
                        for (int q = 0; q < 4; ++q) { const float c0 = bflo(vc[q]), c1 = bfhi(vc[q]), f0 = bflo(vf[q]), f1 = bfhi(vf[q]);
                            w[q] = pk2(c0 + (f0 - c0) * g[2 * q], c1 + (f1 - c1) * g[2 * q + 1]); }
                    } else {
                        const float sc = (col0 + bj * HALF) < qcols ? 0.125f : 1.0f;
                        w.x = pk2(act_c<ACT>(v0[0]) * sc, act_c<ACT>(v0[1]) * sc); w.y = pk2(act_c<ACT>(v0[2]) * sc, act_c<ACT>(v0[3]) * sc);
                        w.z = pk2(act_c<ACT>(v1[0]) * sc, act_c<ACT>(v1[1]) * sc); w.w = pk2(act_c<ACT>(v1[2]) * sc, act_c<ACT>(v1[3]) * sc);
                    }
                    *(u32x4*)op = w;
                }
            }
    }
    DI void operator()(const f32x4 (&acc)[2][2][4][2], const Unit& u, const int wid) const {
        const int lane = lane_opaque(), wr = wid >> 2, wc = wid & 3, fr = lane & 15, fq = lane >> 4;
        const int row0 = u.pm * BM + wr * 64 + fr;
        if (perm()) {
            const int col0 = u.pn * BM + wc * 32 + 8 * fq;
            f32x4 bv[2][2];
#pragma unroll
            for (int bj = 0; bj < 2; ++bj)
#pragma unroll
                for (int n = 0; n < 2; ++n) bv[bj][n] = bias ? *(const f32x4*)(bias + col0 + bj * HALF + 4 * n) : (f32x4){0.f, 0.f, 0.f, 0.f};
            if (mode == EM_VMIX) perm_body<-1>(acc, bv, row0, col0);
            else if (act == ACT_RELU2) perm_body<ACT_RELU2>(acc, bv, row0, col0);
            else if (act == ACT_TANH) perm_body<ACT_TANH>(acc, bv, row0, col0);
            else if (act == ACT_SIGMOID) perm_body<ACT_SIGMOID>(acc, bv, row0, col0);
            else perm_body<ACT_NONE>(acc, bv, row0, col0);
        } else {
            const int col0 = u.pn * BM + wc * 32 + 4 * fq;
            if (mode == EM_RESID) { if (dry) flat_body<2>(acc, row0, col0); else flat_body<0>(acc, row0, col0); }
            else flat_body<1>(acc, row0, col0);
        }
    }
    template <int W  > DI void flat_body(const f32x4 (&acc)[2][2][4][2], const int row0, const int col0) const {
#pragma unroll
        for (int bj = 0; bj < 2; ++bj)
#pragma unroll
            for (int n = 0; n < 2; ++n) {
                const int col = col0 + bj * HALF + n * 16;
                const f32x4 bv = bias ? *(const f32x4*)(bias + col) : (f32x4){0.f, 0.f, 0.f, 0.f};
#pragma unroll
                for (int ai = 0; ai < 2; ++ai)
#pragma unroll
                    for (int m = 0; m < 4; ++m) {
                        const size_t off = (size_t)(row0 + ai * HALF + m * 16) * ldc + col;
                        f32x4 v = acc[ai][bj][m][n] + bv;
                        if (W == 0) v = v + *(const f32x4*)((const float*)p1 + off);
                        else if (W == 2) v = *(const f32x4*)((const float*)out + off) + 0.0f * v;
                        else { v[0] = __expf(-0.60653066f * sigmoidf_(v[0])); v[1] = __expf(-0.60653066f * sigmoidf_(v[1])); v[2] = __expf(-0.60653066f * sigmoidf_(v[2])); v[3] = __expf(-0.60653066f * sigmoidf_(v[3])); }
                        *(f32x4*)((float*)out + off) = v;
                    }
            }
    }
};

template <class Sched>
DI void gemm_phase(LAS unsigned char* lds, const Gemm g, const Sched& S, const Epi& E, const int wid) {
    const int lane = lane_opaque(), tid = wid * 64 + lane, wr = wid >> 2, wc = wid & 3, fr = lane & 15, fq = lane >> 4;
    const int K = g.K, nt = K / BK;
    const bool PERM = E.perm();
    unsigned voffA[2], voffB[2];
#pragma unroll
    for (int i = 0; i < 2; ++i) { int R, C; stage_rc(tid * 16 + i * 8192, R, C); const int Rb = PERM ? ((R & ~31) + perm32(R & 31)) : R;
        voffA[i] = (unsigned)(R * g.lda + C) * 2u; voffB[i] = (unsigned)(Rb * g.ldb + C) * 2u; }
    const size_t kstep = (size_t)(BK * 2);
    const size_t hstepA = (size_t)HALF * g.lda * 2, hstepB = (size_t)HALF * g.ldb * 2;
    const size_t tstepA = 2 * hstepA, tstepB = 2 * hstepB;
    const unsigned ldsw = (unsigned)wid * 1024u;
    const int aoff = lds_byte(wr * 64 + fr, fq * 8), boff = lds_byte(wc * 32 + fr, fq * 8);
#define PG8_SA(b, h) (((b) * 2 + (h)) * HTB)
#define PG8_SB(b, h) ((4 + (b) * 2 + (h)) * HTB)
#define PG8_STAGE(bufoff, gbase, voff) do { _Pragma("unroll") for (int _i = 0; _i < 2; ++_i) \
        __builtin_amdgcn_global_load_lds((const unsigned*)((const char*)(gbase) + (voff)[_i]), (LAS unsigned*)(lds + (bufoff) + ldsw + _i * 8192), 16, 0, 0); } while (0)
#define PG8_LDA(dst, b, h) do { _Pragma("unroll") for (int m = 0; m < 4; ++m) _Pragma("unroll") for (int k = 0; k < 2; ++k) dst[m][k] = *(const LAS bf16x8*)(lds + PG8_SA(b, h) + aoff + m * 2048 + k * 1024); } while (0)
#define PG8_LDB(dst, b, h) do { _Pragma("unroll") for (int n = 0; n < 2; ++n) _Pragma("unroll") for (int k = 0; k < 2; ++k) dst[n][k] = *(const LAS bf16x8*)(lds + PG8_SB(b, h) + boff + n * 2048 + k * 1024); } while (0)
#define PG8_MMA(ai, bj, At, Bt) do { __builtin_amdgcn_s_setprio(1); _Pragma("unroll") for (int m = 0; m < 4; ++m) _Pragma("unroll") for (int n = 0; n < 2; ++n) _Pragma("unroll") for (int k = 0; k < 2; ++k) \
        acc[ai][bj][m][n] = __builtin_amdgcn_mfma_f32_16x16x32_bf16(Bt[n][k], At[m][k], acc[ai][bj][m][n], 0, 0, 0); __builtin_amdgcn_s_setprio(0); } while (0)
#define PG8_WAIT_V(n) asm volatile("s_waitcnt vmcnt(" #n ")" ::: "memory")
#define PG8_WAIT_L(n) asm volatile("s_waitcnt lgkmcnt(" #n ")" ::: "memory")
#define PG8_BAR __builtin_amdgcn_s_barrier()
#define PG8_SCHED __builtin_amdgcn_sched_barrier(0)
    Unit cur, nxt; int ui = 0;
    if (!S.next(0, cur)) return;
    f32x4 acc[2][2][4][2];
#pragma unroll
    for (int a = 0; a < 2; ++a)
#pragma unroll
        for (int b = 0; b < 2; ++b)
#pragma unroll
            for (int m = 0; m < 4; ++m)
#pragma unroll
                for (int n = 0; n < 2; ++n) acc[a][b][m][n] = (f32x4){0.f, 0.f, 0.f, 0.f};
    bf16x8 At[4][2], B0[2][2], B1[2][2];
    const char* cA = (const char*)g.A + (size_t)cur.pm * tstepA; const char* cB = (const char*)g.Bt + (size_t)cur.pn * tstepB;
    PG8_STAGE(PG8_SB(0, 0), cB, voffB); PG8_STAGE(PG8_SB(0, 1), cB + hstepB, voffB); PG8_STAGE(PG8_SA(0, 0), cA, voffA); PG8_STAGE(PG8_SA(0, 1), cA + hstepA, voffA);
    if (wr == 1) PG8_BAR;
    PG8_WAIT_V(2); PG8_BAR;
    PG8_STAGE(PG8_SB(1, 0), cB + kstep, voffB); PG8_STAGE(PG8_SA(1, 0), cA + kstep, voffA); PG8_STAGE(PG8_SB(1, 1), cB + hstepB + kstep, voffB);
    PG8_WAIT_V(6); PG8_BAR;
    for (;;) {
        const bool has_next = S.next(ui + 1, nxt);
        const char* nA = has_next ? (const char*)g.A + (size_t)nxt.pm * tstepA : cA; const char* nB = has_next ? (const char*)g.Bt + (size_t)nxt.pn * tstepB : cB;
        for (int t = 0; t < nt; t += 2) {
            const bool last = (t == nt - 2);
            const char* a1 = cA + (size_t)(t + 1) * kstep;
            const char* a2 = last ? nA : cA + (size_t)(t + 2) * kstep; const char* b2 = last ? nB : cB + (size_t)(t + 2) * kstep;
            const char* a3 = a2 + kstep; const char* b3 = b2 + kstep;
            PG8_LDB(B0, 0, 0); PG8_LDB(B1, 0, 1); PG8_SCHED; PG8_LDA(At, 0, 0); PG8_STAGE(PG8_SA(1, 1), a1 + hstepA, voffA);
            PG8_WAIT_V(8); PG8_WAIT_L(0); PG8_BAR; PG8_MMA(0, 0, At, B0); PG8_MMA(0, 1, At, B1); PG8_BAR; PG8_SCHED;
            PG8_LDA(At, 0, 1); PG8_STAGE(PG8_SB(0, 0), b2, voffB); PG8_STAGE(PG8_SB(0, 1), b2 + hstepB, voffB); PG8_STAGE(PG8_SA(0, 0), a2, voffA);
            PG8_WAIT_V(8); PG8_WAIT_L(0); PG8_BAR; PG8_MMA(1, 0, At, B0); PG8_MMA(1, 1, At, B1); PG8_BAR; PG8_SCHED;
            PG8_LDB(B0, 1, 0); PG8_LDB(B1, 1, 1); PG8_SCHED; PG8_LDA(At, 1, 0); PG8_STAGE(PG8_SA(0, 1), a2 + hstepA, voffA);
            PG8_WAIT_V(8); PG8_WAIT_L(0); PG8_BAR; PG8_MMA(0, 0, At, B0); PG8_MMA(0, 1, At, B1); PG8_BAR; PG8_SCHED;
            PG8_LDA(At, 1, 1); PG8_STAGE(PG8_SB(1, 0), b3, voffB); PG8_STAGE(PG8_SB(1, 1), b3 + hstepB, voffB); PG8_STAGE(PG8_SA(1, 0), a3, voffA);
            PG8_WAIT_V(8); PG8_WAIT_L(0); PG8_BAR; PG8_MMA(1, 0, At, B0); PG8_MMA(1, 1, At, B1); PG8_BAR; PG8_SCHED;
        }
        if (wr == 0) PG8_BAR;
        E(acc, cur, wid);
        if (!has_next) break;
#pragma unroll
        for (int a = 0; a < 2; ++a)
#pragma unroll
            for (int b = 0; b < 2; ++b)
#pragma unroll
                for (int m = 0; m < 4; ++m)
#pragma unroll
                    for (int n = 0; n < 2; ++n) acc[a][b][m][n] = (f32x4){0.f, 0.f, 0.f, 0.f};
        cur = nxt; cA = nA; cB = nB; ++ui;
        if (wr == 1) PG8_BAR;
    }
    PG8_WAIT_V(0);
    PG8_BAR;
#undef PG8_SA
#undef PG8_SB
#undef PG8_STAGE
#undef PG8_LDA
#undef PG8_LDB
#undef PG8_MMA
#undef PG8_WAIT_V
#undef PG8_WAIT_L
#undef PG8_BAR
#undef PG8_SCHED
}
}

struct Args { const float* in[33]; float* out; unsigned char* ws; int op_lo, op_hi; };
struct Ctx { float* out; unsigned char* ws; int bid, G, w0; };
DI const float* inp_(const Args& a, int i) { return a.in[i]; }
DI const float* inp_(const Ctx& a, int i) {
    const unsigned* p = (const unsigned*)a.ws + 2 * i;
    const unsigned long long lo = (unsigned)__builtin_amdgcn_readfirstlane((int)p[0]), hi = (unsigned)__builtin_amdgcn_readfirstlane((int)p[1]);
    return (const float*)(lo | (hi << 32));
}
#define INP(a, i) inp_(a, i)

enum { K_PROLOGUE = 0, K_GEMM, K_MIX, K_NORM, K_SCAN, K_GNGATE, K_ATTN, K_CONVGATE, K_FINAL };
struct Op {
    int kind, sync;
    const bf16_t* A; const bf16_t* Bt; int lda, ldb, N, K, shift;
    int emode, act; void* out; int ldc; const float* bias; const void* p1; int qcols;
    int layer, idx;
    const float* xin;
    int pad_[4];
};
static_assert(sizeof(Op) == 128, "Op is one 128-byte record");
constexpr size_t WS_OPTAB = 4096;

constexpr int NOPS_RWKV0 = 13, NOPS_RWKV1 = 15, NOPS_SWA = 4, NOPS_CONV = 4, NOPS_FFN = 3;
constexpr int NOPS_TOTAL = 1 + (NOPS_RWKV0 + NOPS_FFN) + (NOPS_SWA + NOPS_FFN) + (NOPS_CONV + NOPS_FFN) + (NOPS_RWKV1 + NOPS_FFN) + 1;

DI void set_gemm(Op& d, const bf16_t* A, int lda, const bf16_t* Bt, int ldb, int N, int K, int shift,
                                                  int emode, int act, void* out, int ldc, const float* bias, const void* p1, int qcols, int sync) {
    d.kind = K_GEMM; d.A = A; d.lda = lda; d.Bt = Bt; d.ldb = ldb; d.N = N; d.K = K; d.shift = shift; d.emode = emode; d.act = act; d.out = out; d.ldc = ldc; d.bias = bias; d.p1 = p1; d.qcols = qcols; d.sync = sync;
}

template <class AT> DI void ffn_ops(Op& d, int o, int L, const AT& a) {
    unsigned char* ws = a.ws; float* X = a.out;
    bf16_t* H = (bf16_t*)(ws + WS_AR); bf16_t* HID = (bf16_t*)(ws + WS_AR + 64 * MiB);
    bf16_t* WUP = (bf16_t*)(ws + (L == 1 ? WS_MLP2 : WS_MLP)); bf16_t* WDN = WUP + (size_t)16 * E_M;
    if (o == 0) { d.kind = K_NORM; d.sync = 1; d.layer = L; d.idx = 1; d.xin = X; }
    else if (o == 1) set_gemm(d, H, DM, WUP, DM, DFF, DM, 0, pg8::EM_BF16, pg8::ACT_RELU2, HID, DFF, nullptr, nullptr, 0, 1);
    else set_gemm(d, HID, DFF, WDN, DFF, DM, DFF, 0, pg8::EM_RESID, 0, X, DM, nullptr, X, 0, 1);
}

template <class AT> DI void rwkv_ops(Op& d, int o, int L, int ia, const AT& a) {
    unsigned char* ws = a.ws; float* X = a.out;
    bf16_t* RW = (bf16_t*)(ws + (ia == 0 ? WS_RW0 : WS_RW1));
    unsigned char* AR = ws + WS_AR;
    bf16_t *XR = (bf16_t*)(AR), *XK = (bf16_t*)(AR + 64 * MiB), *XV = (bf16_t*)(AR + 128 * MiB), *XW = (bf16_t*)(AR + 192 * MiB), *XA = (bf16_t*)(AR + 256 * MiB), *XG = (bf16_t*)(AR + 320 * MiB);
    bf16_t *R = (bf16_t*)(AR + 384 * MiB), *Kb = (bf16_t*)(AR + 448 * MiB), *Vb = (bf16_t*)(ia == 0 ? ws + WS_VFIRST : AR + 512 * MiB), *L1 = (bf16_t*)(AR + 576 * MiB), *YG = (bf16_t*)(AR + 608 * MiB);
    float* DEC = (float*)(AR); bf16_t* AG = (bf16_t*)(AR + 128 * MiB); bf16_t* G = (bf16_t*)(AR + 192 * MiB);
    const float* xin = (L == 0) ? INP(a, 0) : X;
    const int hasv = ia;
    d.layer = L; d.idx = ia; d.xin = xin;
    int k = o;
    if (k == 0) { d.kind = K_MIX; d.sync = 1; return; }
    k -= 1;
    if (k == 0) { set_gemm(d, XR, DM, RW + RW_WR, DM, DM, DM, 0, pg8::EM_BF16, 0, R, DM, nullptr, nullptr, 0, 0); return; }
    if (k == 1) { set_gemm(d, XK, DM, RW + RW_WK, DM, DM, DM, 0, pg8::EM_BF16, 0, Kb, DM, nullptr, nullptr, 0, 0); return; }
    if (k == 2) { set_gemm(d, XV, DM, RW + RW_WV, DM, DM, DM, 0, pg8::EM_BF16, 0, Vb, DM, nullptr, nullptr, 0, 0); return; }
    if (k == 3) { set_gemm(d, XW, DM, RW + RW_L1, DM, 256, DM, 0, pg8::EM_BF16, pg8::ACT_TANH, L1, 1024, nullptr, nullptr, 0, 0); return; }
    if (k == 4) { set_gemm(d, XA, DM, RW + RW_L1 + 256 * DM, DM, 256, DM, 64, pg8::EM_BF16, 0, L1 + 256, 1024, nullptr, nullptr, 0, 0); return; }
    if (k == 5) { set_gemm(d, XG, DM, RW + RW_L1 + 512 * DM, DM, 256, DM, 128, pg8::EM_BF16, pg8::ACT_SIGMOID, L1 + 512, 1024, nullptr, nullptr, 0, hasv ? 0 : 1); if (!hasv) d.idx = 8; return; }
    k -= 6;
    if (hasv) { if (k == 0) { set_gemm(d, XV, DM, RW + RW_L1 + 768 * DM, DM, 256, DM, 192, pg8::EM_BF16, 0, L1 + 768, 1024, nullptr, nullptr, 0, 1); return; } k -= 1; }
    if (k == 0) { set_gemm(d, L1, 1024, RW + RW_W2, 128, DM, 128, 0, pg8::EM_DECAY, 0, DEC, DM, INP(a, 7) + ia * DM, nullptr, 0, 0); return; }
    if (k == 1) { set_gemm(d, L1 + 256, 1024, RW + RW_A2, 128, DM, 128, 0, pg8::EM_BF16, pg8::ACT_SIGMOID, AG, DM, INP(a, 10) + ia * DM, nullptr, 0, 0); return; }
    if (k == 2) { set_gemm(d, L1 + 512, 1024, RW + RW_G2, 256, DM, 256, 0, pg8::EM_BF16, 0, G, DM, nullptr, nullptr, 0, hasv ? 0 : 1); return; }
    k -= 3;
    if (hasv) { if (k == 0) { set_gemm(d, L1 + 768, 1024, RW + RW_V2, 128, DM, 128, 0, pg8::EM_VMIX, 0, Vb, DM, INP(a, 13), ws + WS_VFIRST, 0, 1); return; } k -= 1; }
    if (k == 0) { d.kind = K_SCAN; d.sync = 1; return; }
    if (k == 1) { d.kind = K_GNGATE; d.sync = 1; return; }
    set_gemm(d, YG, DM, RW + RW_WO, DM, DM, DM, 0, pg8::EM_RESID, 0, X, DM, nullptr, xin, 0, 1);
}

template <class AT> DI void swa_ops(Op& d, int o, int L, const AT& a) {
    unsigned char* ws = a.ws; float* X = a.out; unsigned char* AR = ws + WS_AR;
    bf16_t* H = (bf16_t*)AR; bf16_t* QKV = (bf16_t*)(AR + 64 * MiB); bf16_t* O = (bf16_t*)(AR + 144 * MiB);
    bf16_t* WQKV = (bf16_t*)(ws + WS_SWA); bf16_t* WO = (bf16_t*)(ws + WS_SWA + 10 * MiB);
    d.layer = L; d.idx = 0; d.xin = X;
    if (o == 0) { d.kind = K_NORM; d.sync = 1; d.idx = 0; return; }
    if (o == 1) { set_gemm(d, H, DM, WQKV, DM, 2560, DM, 0, pg8::EM_BF16, 0, QKV, 2560, INP(a, 24), nullptr, 2048, 1); d.idx = 7; return; }
    if (o == 2) { d.kind = K_ATTN; d.sync = 1; return; }
    set_gemm(d, O, DM, WO, DM, DM, DM, 0, pg8::EM_RESID, 0, X, DM, INP(a, 26), X, 0, 1);
}

template <class AT> DI void conv_ops(Op& d, int o, int L, const AT& a) {
    unsigned char* ws = a.ws; float* X = a.out; unsigned char* AR = ws + WS_AR;
    bf16_t* H = (bf16_t*)AR; bf16_t* BCH = (bf16_t*)(AR + 64 * MiB); bf16_t* Z = (bf16_t*)(AR + 256 * MiB);
    bf16_t* WIN = (bf16_t*)(ws + WS_CONV); bf16_t* WOUT = (bf16_t*)(ws + WS_CONV + 24 * MiB);
    d.layer = L; d.idx = 0; d.xin = X;
    if (o == 0) { d.kind = K_NORM; d.sync = 1; d.idx = 0; return; }
    if (o == 1) { set_gemm(d, H, DM, WIN, DM, 6144, DM, 0, pg8::EM_BF16, 0, BCH, 6144, nullptr, nullptr, 0, 1); return; }
    if (o == 2) { d.kind = K_CONVGATE; d.sync = 1; return; }
    set_gemm(d, Z, DM, WOUT, DM, DM, DM, 0, pg8::EM_RESID, 0, X, DM, nullptr, X, 0, 1);
}

template <class AT> DI void build_op(Op& d, int op, const AT& a) {
    d.kind = K_FINAL; d.sync = 0; d.A = nullptr; d.Bt = nullptr; d.lda = d.ldb = d.N = d.K = d.shift = 0; d.emode = d.act = 0; d.out = nullptr; d.ldc = 0; d.bias = nullptr; d.p1 = nullptr; d.qcols = 0;
    d.layer = 0; d.idx = 0; d.xin = a.out;
    int o = op;
    if (o == 0) { d.kind = K_PROLOGUE; d.sync = 1; return; }
    o -= 1;
    if (o < NOPS_RWKV0) { rwkv_ops(d, o, 0, 0, a); return; } o -= NOPS_RWKV0;
    if (o < NOPS_FFN) { ffn_ops(d, o, 0, a); return; } o -= NOPS_FFN;
    if (o < NOPS_SWA) { swa_ops(d, o, 1, a); return; } o -= NOPS_SWA;
    if (o < NOPS_FFN) { ffn_ops(d, o, 1, a); return; } o -= NOPS_FFN;
    if (o < NOPS_CONV) { conv_ops(d, o, 2, a); return; } o -= NOPS_CONV;
    if (o < NOPS_FFN) { ffn_ops(d, o, 2, a); return; } o -= NOPS_FFN;
    if (o < NOPS_RWKV1) { rwkv_ops(d, o, 3, 1, a); return; } o -= NOPS_RWKV1;
    if (o < NOPS_FFN) { ffn_ops(d, o, 3, a); return; } o -= NOPS_FFN;
    d.kind = K_FINAL; d.sync = 0;
}

DI void tr_load(const float* W, int Ks, int Ns, int item, int nblk, int lane, f32x4 (&v)[8]) {
    const int kb = item / nblk, nb = item % nblk, k0 = 64 * kb, n0 = 32 * nb;
    const int nn = (lane & 7) * 4; const bool nok = n0 < Ns;
#pragma unroll
    for (int i = 0; i < 8; ++i) {
        const int k = k0 + i * 8 + (lane >> 3);
        v[i] = (f32x4){0.f, 0.f, 0.f, 0.f};
        if (nok && k < Ks) v[i] = *(const f32x4*)(W + (size_t)k * Ns + n0 + nn);
    }
}
DI void tr_finish(bf16_t* WT, int Kd, float* scr, int item, int nblk, int lane, const f32x4 (&v)[8]) {
    const int kb = item / nblk, nb = item % nblk, k0 = 64 * kb, n0 = 32 * nb;
    const int nn = (lane & 7) * 4;
#pragma unroll
    for (int i = 0; i < 8; ++i) { float* sp = scr + (i * 8 + (lane >> 3)) * 33 + nn; sp[0] = v[i][0]; sp[1] = v[i][1]; sp[2] = v[i][2]; sp[3] = v[i][3]; }
    asm volatile("s_waitcnt lgkmcnt(0)" ::: "memory");
    const int c = lane & 7;
#pragma unroll
    for (int j = 0; j < 4; ++j) { const int nr = (lane >> 3) + 8 * j; const float* s = scr + (8 * c) * 33 + nr;
        u32x4 o; o.x = pk2(s[0 * 33], s[1 * 33]); o.y = pk2(s[2 * 33], s[3 * 33]); o.z = pk2(s[4 * 33], s[5 * 33]); o.w = pk2(s[6 * 33], s[7 * 33]);
        *(u32x4*)(WT + (size_t)(n0 + nr) * Kd + k0 + 8 * c) = o; }
    asm volatile("s_waitcnt lgkmcnt(0)" ::: "memory");
}
DI void convert_w(const float* W, int Ks, int Ns, bf16_t* WT, int Kd, int Nd, float* scr, int gw, int NGW, int lane) {
    const int nblk = Nd / 32, nitems = (Kd / 64) * nblk;
    f32x4 cur[8], nxt[8];
    if (gw < nitems) tr_load(W, Ks, Ns, gw, nblk, lane, cur);
    for (int it = gw; it < nitems; it += NGW) {
        if (it + NGW < nitems) tr_load(W, Ks, Ns, it + NGW, nblk, lane, nxt);
        tr_finish(WT, Kd, scr, it, nblk, lane, cur);
#pragma unroll
        for (int i = 0; i < 8; ++i) cur[i] = nxt[i];
    }
}

struct CvJob { const float* W; bf16_t* WT; int Ks, Ns, Kd, nblk, nitems; };
DI void cv_set(CvJob& j, const float* W, int Ks, int Ns, bf16_t* WT, int Kd, int Nd) { j.W = W; j.WT = WT; j.Ks = Ks; j.Ns = Ns; j.Kd = Kd; j.nblk = Nd / 32; j.nitems = (Kd / 64) * (Nd / 32); }
constexpr int CV_NJOBS = 28;
DI void cv_job(CvJob& j, int id, const Args& a) {
    unsigned char* ws = a.ws; const size_t DD = (size_t)DM * DM;
    if (id < 24) {
        const int ia = id / 12, k = id % 12;
        bf16_t* RW = (bf16_t*)(ws + (ia == 0 ? WS_RW0 : WS_RW1));
        if (k < 3) cv_set(j, a.in[5] + (size_t)(ia * 3 + k) * DD, DM, DM, RW + RW_WR + (size_t)k * 4 * E_M, DM, DM);
        else if (k == 3) cv_set(j, a.in[8] + (size_t)ia * DM * 96, DM, 96, RW + RW_L1, DM, 256);
        else if (k == 4) cv_set(j, a.in[11] + (size_t)ia * DM * 96, DM, 96, RW + RW_L1 + 256 * DM, DM, 256);
        else if (k == 5) cv_set(j, a.in[16] + (size_t)ia * DM * 256, DM, 256, RW + RW_L1 + 512 * DM, DM, 256);
        else if (k == 6) cv_set(j, a.in[14], DM, 64, RW + RW_L1 + 768 * DM, DM, ia == 1 ? 256 : 0);
        else if (k == 7) cv_set(j, a.in[9] + (size_t)ia * 96 * DM, 96, DM, RW + RW_W2, 128, DM);
        else if (k == 8) cv_set(j, a.in[12] + (size_t)ia * 96 * DM, 96, DM, RW + RW_A2, 128, DM);
        else if (k == 9) cv_set(j, a.in[17] + (size_t)ia * 256 * DM, 256, DM, RW + RW_G2, 256, DM);
        else if (k == 10) cv_set(j, a.in[15], 64, DM, RW + RW_V2, 128, ia == 1 ? DM : 0);
        else cv_set(j, a.in[6] + (size_t)ia * DD, DM, DM, RW + RW_WO, DM, DM);
    } else if (id == 24) cv_set(j, a.in[23], DM, 2560, (bf16_t*)(ws + WS_SWA), DM, 2560);
    else if (id == 25) cv_set(j, a.in[25], DM, DM, (bf16_t*)(ws + WS_SWA + 10 * MiB), DM, DM);
    else if (id == 26) cv_set(j, a.in[28], DM, 6144, (bf16_t*)(ws + WS_CONV), DM, 0);
    else cv_set(j, a.in[30], DM, DM, (bf16_t*)(ws + WS_CONV + 24 * MiB), DM, 0);
}
DI bool cv_advance(CvJob& j, int& id, int& it, int step, const Args& a) {
    it += step;
    while (it >= j.nitems) { it -= j.nitems; ++id; if (id >= CV_NJOBS) return false; cv_job(j, id, a); }
    return true;
}
DI void prologue_phase(unsigned char* lds, const Args& a, const int w0) {
    const int lane = lane_opaque(), wave = w0;
    float* scr = (float*)(lds + wave * 16384);
    const int gw = blockIdx.x * NWAVES + wave, NGW = gridDim.x * NWAVES;
    CvJob jc, jn; int idc = 0, itc = 0;
    cv_job(jc, 0, a);
    bool okc = cv_advance(jc, idc, itc, gw, a);
    f32x4 cur[8], nxt[8];
    if (okc) tr_load(jc.W, jc.Ks, jc.Ns, itc, jc.nblk, lane, cur);
    while (okc) {
        jn = jc; int idn = idc, itn = itc;
        const bool okn = cv_advance(jn, idn, itn, NGW, a);
        if (okn) tr_load(jn.W, jn.Ks, jn.Ns, itn, jn.nblk, lane, nxt);
        tr_finish(jc.WT, jc.Kd, scr, itc, jc.nblk, lane, cur);
#pragma unroll
        for (int i = 0; i < 8; ++i) cur[i] = nxt[i];
        jc = jn; idc = idn; itc = itn; okc = okn;
    }
}

DI void store_pair16(bf16_t* rowbase, int j, int lane, u32x2 w0, u32x2 w1) {
    const bool odd = lane & 1;
    const u32x2 send = odd ? w0 : w1;
    u32x2 recv;
    recv.x = (unsigned)__builtin_amdgcn_update_dpp(0, (int)send.x, 0xB1, 0xF, 0xF, true);
    recv.y = (unsigned)__builtin_amdgcn_update_dpp(0, (int)send.y, 0xB1, 0xF, 0xF, true);
    const u32x4 o = odd ? (u32x4){recv.x, recv.y, w1.x, w1.y} : (u32x4){w0.x, w0.y, recv.x, recv.y};
    *(u32x4*)(rowbase + 256 * (j + (odd ? 1 : 0)) + 8 * (lane >> 1)) = o;
}
DI void load_row(const float* xrow, int lane, f32x4 (&v)[8]) {
#pragma unroll
    for (int j = 0; j < 8; ++j) v[j] = *(const f32x4*)(xrow + j * 256 + lane * 4);
}
DI void finish_row(const float* g, int lane, f32x4 (&v)[8]) {
    float s = 0.f;
#pragma unroll
    for (int j = 0; j < 8; ++j) s += (v[j][0] * v[j][0] + v[j][1] * v[j][1]) + (v[j][2] * v[j][2] + v[j][3] * v[j][3]);
    const float rstd = rsqrtf(wave_sum(s) * (1.0f / DM) + 1e-6f);
#pragma unroll
    for (int j = 0; j < 8; ++j) { const f32x4 gg = *(const f32x4*)(g + j * 256 + lane * 4); v[j] = v[j] * rstd * gg; }
}
DI void finish_row(const LAS float* g, int lane, f32x4 (&v)[8]) {
    float s = 0.f;
#pragma unroll
    for (int j = 0; j < 8; ++j) s += (v[j][0] * v[j][0] + v[j][1] * v[j][1]) + (v[j][2] * v[j][2] + v[j][3] * v[j][3]);
    const float rstd = rsqrtf(wave_sum(s) * (1.0f / DM) + 1e-6f);
#pragma unroll
    for (int j = 0; j < 8; ++j) { const f32x4 gg = *(const LAS f32x4*)(g + j * 256 + lane * 4); v[j] = v[j] * rstd * gg; }
}
DI void norm_row(const float* xrow, const float* g, int lane, f32x4 (&v)[8]) { load_row(xrow, lane, v); finish_row(g, lane, v); }
DI void norm_row(const float* xrow, const LAS float* g, int lane, f32x4 (&v)[8]) { load_row(xrow, lane, v); finish_row(g, lane, v); }

DI void norm_phase(unsigned char* lds, const Ctx& a, const Op& d) {
    const int tid = TID_OF(a), lane = tid & 63, wave = tid >> 6;
    const int gw = a.bid * NWAVES + wave, NGW = a.G * NWAVES;
    if (false) {
        float* scr = (float*)(lds + wave * 16384);
        convert_w(INP(a, 31) + (size_t)d.layer * DM * DFF, DM, DFF, (bf16_t*)(a.ws + WS_MLP), DM, DFF, scr, gw, NGW, lane);
        convert_w(INP(a, 32) + (size_t)d.layer * DM * DFF, DFF, DM, (bf16_t*)(a.ws + WS_MLP + 32 * MiB), DFF, DM, scr, gw, NGW, lane);
    }
    LAS float* g = (LAS float*)(LAS unsigned char*)lds;
    {
        const float* gg = (d.idx == 1 ? INP(a, 2) : INP(a, 1)) + d.layer * DM;
        __syncthreads();
        for (int i = tid * 4; i < DM; i += NTHREADS * 4) *(LAS f32x4*)(g + i) = *(const f32x4*)(gg + i);
        __syncthreads();
    }
    bf16_t* H = (bf16_t*)(a.ws + WS_AR);
    f32x4 nx[8];
    if (gw < MTOK) load_row(d.xin + (size_t)gw * DM, lane, nx);
    for (int m = gw; m < MTOK; m += NGW) {
        f32x4 v[8];
#pragma unroll
        for (int j = 0; j < 8; ++j) v[j] = nx[j];
        if (m + NGW < MTOK) load_row(d.xin + (size_t)(m + NGW) * DM, lane, nx);
        finish_row(g, lane, v);
#pragma unroll
        for (int j = 0; j < 8; j += 2) { u32x2 w0, w1; w0.x = pk2(v[j][0], v[j][1]); w0.y = pk2(v[j][2], v[j][3]); w1.x = pk2(v[j + 1][0], v[j + 1][1]); w1.y = pk2(v[j + 1][2], v[j + 1][3]);
            store_pair16(H + (size_t)m * DM, j, lane, w0, w1); }
    }
}

DI void final_phase(unsigned char* lds, const Ctx& a) {
    const int tid = TID_OF(a), lane = tid & 63, wave = tid >> 6;
    const int gw = a.bid * NWAVES + wave, NGW = a.G * NWAVES;
    LAS float* g = (LAS float*)(LAS unsigned char*)lds;
    { const float* gg = INP(a, 3); for (int i = tid * 4; i < DM; i += NTHREADS * 4) *(LAS f32x4*)(g + i) = *(const f32x4*)(gg + i); __syncthreads(); }
    for (int m = gw; m < MTOK; m += NGW) {
        f32x4 v[8]; norm_row(a.out + (size_t)m * DM, g, lane, v);
#pragma unroll
        for (int j = 0; j < 8; ++j) *(f32x4*)(a.out + (size_t)m * DM + j * 256 + lane * 4) = v[j];
    }
}

DI void mix_phase(unsigned char* lds, const Ctx& a, const Op& d) {
    const int tid = TID_OF(a), lane = tid & 63, wave = tid >> 6;
    const int gw = a.bid * NWAVES + wave, NGW = a.G * NWAVES;
    LAS float* g = (LAS float*)(LAS unsigned char*)lds; LAS float* mu = g + DM;
    {
        const float* gg = INP(a, 1) + d.layer * DM; const float* mg = INP(a, 4) + (size_t)d.idx * 6 * DM;
        for (int i = tid * 4; i < DM; i += NTHREADS * 4) *(LAS f32x4*)(g + i) = *(const f32x4*)(gg + i);
        for (int i = tid * 4; i < 6 * DM; i += NTHREADS * 4) *(LAS f32x4*)(mu + i) = *(const f32x4*)(mg + i);
        __syncthreads();
    }
    unsigned char* AR = a.ws + WS_AR;
    for (int ch = gw; ch < MTOK / 8; ch += NGW) {
        const int m0 = ch * 8;
        f32x4 prev[8], cur[8];
        if ((m0 % SEQ) == 0) {
#pragma unroll
            for (int j = 0; j < 8; ++j) prev[j] = (f32x4){0.f, 0.f, 0.f, 0.f};
        } else norm_row(d.xin + (size_t)(m0 - 1) * DM, g, lane, prev);
        f32x4 nx[8];
        load_row(d.xin + (size_t)m0 * DM, lane, nx);
        for (int r = 0; r < 8; ++r) {
            const int m = m0 + r;
#pragma unroll
            for (int j = 0; j < 8; ++j) cur[j] = nx[j];
            if (r < 7) load_row(d.xin + (size_t)(m + 1) * DM, lane, nx);
            finish_row(g, lane, cur);
#pragma unroll 1
            for (int c = 0; c < 6; ++c) {
                const int slot = (c == 0) ? 0 : (c == 1) ? 3 : (c == 2) ? 1 : (c == 3) ? 2 : (c == 4) ? 4 : 5;
                bf16_t* dst = (bf16_t*)(AR + (size_t)slot * 64 * MiB) + (size_t)m * DM;
#pragma unroll
                for (int j = 0; j < 8; j += 2) {
                    const f32x4 m0_ = *(const LAS f32x4*)(mu + c * DM + j * 256 + lane * 4), m1_ = *(const LAS f32x4*)(mu + c * DM + (j + 1) * 256 + lane * 4);
                    const f32x4 o0 = cur[j] + (prev[j] - cur[j]) * m0_, o1 = cur[j + 1] + (prev[j + 1] - cur[j + 1]) * m1_;
                    u32x2 w0, w1; w0.x = pk2(o0[0], o0[1]); w0.y = pk2(o0[2], o0[3]); w1.x = pk2(o1[0], o1[1]); w1.y = pk2(o1[2], o1[3]);
                    store_pair16(dst, j, lane, w0, w1);
                }
            }
#pragma unroll
            for (int j = 0; j < 8; ++j) prev[j] = cur[j];
        }
    }
}

constexpr int SC_T = 32;
constexpr int SC_BUF = 53248;
DI void scan_phase(unsigned char* lds, const Ctx& a, const Op& d, const int variant) {
    const int tid = TID_OF(a), lane = tid & 63, wave = tid >> 6;
    const int ia = d.idx;
    unsigned char* AR = a.ws + WS_AR;
    const bf16_t *R = (const bf16_t*)(AR + 384 * MiB), *Kb = (const bf16_t*)(AR + 448 * MiB), *Vb = (const bf16_t*)(ia == 0 ? a.ws + WS_VFIRST : AR + 512 * MiB);
    const float* DEC = (const float*)AR; const bf16_t* AG = (const bf16_t*)(AR + 128 * MiB);
    float* Y = (float*)(AR + 256 * MiB);
    const int cgp = tid & 15;
    const int ii = lane >> 4, jg = lane & 15;
    for (int unit = a.bid; unit < NB * 32 * 2; unit += a.G) {
        const int bh = unit >> 1, half = unit & 1, b = bh >> 5, h = bh & 31;
        const int chan = h * 64 + cgp * 4;
        const f32x4 kk4 = *(const f32x4*)(INP(a, 18) + ia * DM + chan), ka4 = *(const f32x4*)(INP(a, 19) + ia * DM + chan);
        const size_t rowbase = (size_t)b * SEQ;
        u32x2 pr, pk, pv, pa; f32x4 pd;
#define SC_LOAD(c, tl, pr, pk, pv, pa, pd) do { const size_t off = (rowbase + (size_t)(c) * SC_T + (tl)) * DM + chan; \
            pr = *(const u32x2*)(R + off); pk = *(const u32x2*)(Kb + off); pv = *(const u32x2*)(Vb + off); pa = *(const u32x2*)(AG + off); pd = *(const f32x4*)(DEC + off); } while (0)
#define SC_STORE(bi, tl, pr, pk, pv, pa, pd) do { float* base = (float*)(lds + (bi) * SC_BUF); \
            const float k0 = bflo(pk.x), k1 = bfhi(pk.x), k2 = bflo(pk.y), k3 = bfhi(pk.y); \
            const float a0 = bflo(pa.x), a1 = bfhi(pa.x), a2 = bflo(pa.y), a3 = bfhi(pa.y); \
            const float r0 = bflo(pr.x), r1 = bfhi(pr.x), r2 = bflo(pr.y), r3 = bfhi(pr.y); \
            float q0 = k0 * kk4[0], q1 = k1 * kk4[1], q2 = k2 * kk4[2], q3 = k3 * kk4[3]; \
            const float n2 = rowsum16((q0 * q0 + q1 * q1) + (q2 * q2 + q3 * q3)); \
            const float inv = 1.0f / fmaxf(sqrtf(n2), 1e-12f); q0 *= inv; q1 *= inv; q2 *= inv; q3 *= inv; \
            const float b0 = q0 * a0, b1 = q1 * a1, b2 = q2 * a2, b3 = q3 * a3; \
            const float e0 = k0 * (1.f + (a0 - 1.f) * ka4[0]), e1 = k1 * (1.f + (a1 - 1.f) * ka4[1]), e2 = k2 * (1.f + (a2 - 1.f) * ka4[2]), e3 = k3 * (1.f + (a3 - 1.f) * ka4[3]); \
            const float br = rowsum16((b0 * r0 + b1 * r1) + (b2 * r2 + b3 * r3)), kr = rowsum16((e0 * r0 + e1 * r1) + (e2 * r2 + e3 * r3)); \
            float* p = base + ((tl) * 16 + cgp) * 20; \
            *(f32x4*)(p) = pd; *(f32x4*)(p + 4) = (f32x4){-q0, -q1, -q2, -q3}; *(f32x4*)(p + 8) = (f32x4){b0, b1, b2, b3}; \
            *(f32x4*)(p + 12) = (f32x4){e0, e1, e2, e3}; *(f32x4*)(p + 16) = (f32x4){pd[0] * r0 - q0 * br, pd[1] * r1 - q1 * br, pd[2] * r2 - q2 * br, pd[3] * r3 - q3 * br}; \
            if ((cgp >> 3) == half) { const float v0 = bflo(pv.x), v1 = bfhi(pv.x), v2 = bflo(pv.y), v3 = bfhi(pv.y); float* vp = base + 10240 + ((tl) * 32 + (cgp & 7) * 4) * 2; \
                *(f32x4*)vp = (f32x4){v0, v0 * kr, v1, v1 * kr}; *(f32x4*)(vp + 4) = (f32x4){v2, v2 * kr, v3, v3 * kr}; } \
            } while (0)
        const bool is_loader = wave >= 4;
        const int ltid = tid & 255, tl0 = ltid >> 4;
        u32x2 pr2, pk2_, pv2, pa2; f32x4 pd2;
        const int rA = (wave & 3) * 8 + 2 * ii;
        f32x2 SA01 = {0.f, 0.f}, SA23 = {0.f, 0.f}, SB01 = {0.f, 0.f}, SB23 = {0.f, 0.f};
#define SC_LOAD2(c) do { SC_LOAD(c, tl0, pr, pk, pv, pa, pd); SC_LOAD(c, tl0 + 16, pr2, pk2_, pv2, pa2, pd2); } while (0)
#define SC_STORE2(bi) do { SC_STORE(bi, tl0, pr, pk, pv, pa, pd); SC_STORE(bi, tl0 + 16, pr2, pk2_, pv2, pa2, pd2); } while (0)
        constexpr int NCH = SEQ / SC_T;
        float* cv_scr = (float*)(lds + 2 * SC_BUF + (wave & 3) * 8448);
        const int cv_total = (ia == 0) ? 32768 : 16384, cv_mask = (ia == 0) ? 3 : 7;
        int cv_item = a.bid * 4 + (wave & 3), cv_pend = -1;
        f32x4 cvr[8];
#define SC_YOUT(c) do { const float* Ys = (const float*)(lds + ((c) & 1) * SC_BUF) + 12288; const int tt = ltid >> 3, e = (ltid & 7) * 4; \
            *(f32x4*)(Y + (rowbase + (size_t)(c) * SC_T + tt) * DM + h * 64 + half * 32 + e) = *(const f32x4*)(Ys + tt * 32 + e); } while (0)
        __syncthreads();
        if (is_loader) { SC_LOAD2(0); SC_STORE2(0); SC_LOAD2(1); }
        __syncthreads();
        for (int c = 0; c < NCH; ++c) {
            const int bi = c & 1;
            float* Yl = (float*)(lds + bi * SC_BUF) + 12288;
            if (is_loader) {
                if ((c & cv_mask) == 0 && cv_item < cv_total) {
                    const int lay = cv_item >> 14, it = cv_item & 16383; const int L = (ia == 0) ? lay : 3;
                    if (it < 8192) tr_load(INP(a, 31) + (size_t)L * DM * DFF, DM, DFF, it, DFF / 32, lane, cvr);
                    else tr_load(INP(a, 32) + (size_t)L * DM * DFF, DFF, DM, it - 8192, DM / 32, lane, cvr);
                    cv_pend = cv_item; cv_item += a.G * 4;
                }
                if ((c & cv_mask) == 2 && cv_pend >= 0) {
                    const int lay = cv_pend >> 14, it = cv_pend & 16383; const int L = (ia == 0) ? lay : 3;
                    bf16_t* WB = (bf16_t*)(a.ws + (L == 1 ? WS_MLP2 : WS_MLP));
                    if (it < 8192) tr_finish(WB, DM, cv_scr, it, DFF / 32, lane, cvr);
                    else tr_finish(WB + (size_t)16 * E_M, DFF, cv_scr, it - 8192, DM / 32, lane, cvr);
                    cv_pend = -1;
                }
                if (c > 0 && !(variant & 4)) SC_YOUT(c - 1);
                if (!(variant & 2)) {
                if (c + 1 < NCH) SC_STORE2(bi ^ 1);
                if (c + 2 < NCH) SC_LOAD2(c + 2);
                }
            } else if (!(variant & 1)) {
                const float* base = (const float*)(lds + bi * SC_BUF);
                const float* rec = base + jg * 20; const float* VVa = base + 10240 + rA * 2;
                f32x4 wA, aA, bA, kA, qA, vA, wB, aB, bB, kB, qB, vB;
#define LO2(x) __builtin_shufflevector(x, x, 0, 1)
#define HI2(x) __builtin_shufflevector(x, x, 2, 3)
#define SC_GET(X, t) do { const float* p = rec + (t) * 320; w##X = *(const f32x4*)p; a##X = *(const f32x4*)(p + 4); b##X = *(const f32x4*)(p + 8); k##X = *(const f32x4*)(p + 12); q##X = *(const f32x4*)(p + 16); \
                v##X = *(const f32x4*)(VVa + (t) * 64); } while (0)
#define SC_STEP(X, t) do { \
                f32x2 pA = SA01 * LO2(a##X); pA = SA23 * HI2(a##X) + pA; f32x2 pB = SB01 * LO2(a##X); pB = SB23 * HI2(a##X) + pB; \
                f32x2 uA = SA01 * LO2(q##X); uA = SA23 * HI2(q##X) + uA; f32x2 uB = SB01 * LO2(q##X); uB = SB23 * HI2(q##X) + uB; \
                float d1 = pA[0] + pA[1], e1 = pB[0] + pB[1], d2 = uA[0] + uA[1], e2 = uB[0] + uB[1]; \
                d1 += dppf<0xB1>(d1); e1 += dppf<0xB1>(e1); d2 += dppf<0xB1>(d2); e2 += dppf<0xB1>(e2); d1 += dppf<0x4E>(d1); e1 += dppf<0x4E>(e1); d2 += dppf<0x4E>(d2); e2 += dppf<0x4E>(e2); \
                d1 += dppf<0x141>(d1); e1 += dppf<0x141>(e1); d2 += dppf<0x141>(d2); e2 += dppf<0x141>(e2); d1 += dppf<0x140>(d1); e1 += dppf<0x140>(e1); d2 += dppf<0x140>(d2); e2 += dppf<0x140>(e2); \
                const f32x2 d1v = {d1, d1}, e1v = {e1, e1}, vav = {v##X[0], v##X[0]}, vbv = {v##X[2], v##X[2]}; \
                SA01 = SA01 * LO2(w##X) + d1v * LO2(b##X) + vav * LO2(k##X); SA23 = SA23 * HI2(w##X) + d1v * HI2(b##X) + vav * HI2(k##X); \
                SB01 = SB01 * LO2(w##X) + e1v * LO2(b##X) + vbv * LO2(k##X); SB23 = SB23 * HI2(w##X) + e1v * HI2(b##X) + vbv * HI2(k##X); \
                if (jg == 0) *(f32x2*)(Yl + (t) * 32 + rA) = (f32x2){d2 + v##X[1], e2 + v##X[3]}; } while (0)
                SC_GET(A, 0);
#pragma unroll 2
                for (int t = 0; t < SC_T; t += 2) {
                    SC_GET(B, t + 1);
                    SC_STEP(A, t);
                    if (t + 2 < SC_T) SC_GET(A, t + 2);
                    SC_STEP(B, t + 1);
                }
#undef LO2
#undef HI2
#undef SC_GET
#undef SC_STEP
            }
            __syncthreads();
        }
        if (is_loader && !(variant & 4)) SC_YOUT(NCH - 1);
        if (is_loader) {
            for (;;) {
                if (cv_pend < 0) { if (cv_item >= cv_total) break;
                    const int lay = cv_item >> 14, it = cv_item & 16383; const int L = (ia == 0) ? lay : 3;
                    if (it < 8192) tr_load(INP(a, 31) + (size_t)L * DM * DFF, DM, DFF, it, DFF / 32, lane, cvr);
                    else tr_load(INP(a, 32) + (size_t)L * DM * DFF, DFF, DM, it - 8192, DM / 32, lane, cvr);
                    cv_pend = cv_item; cv_item += a.G * 4; }
                const int lay = cv_pend >> 14, it = cv_pend & 16383; const int L = (ia == 0) ? lay : 3;
                bf16_t* WB = (bf16_t*)(a.ws + (L == 1 ? WS_MLP2 : WS_MLP));
                if (it < 8192) tr_finish(WB, DM, cv_scr, it, DFF / 32, lane, cvr);
                else tr_finish(WB + (size_t)16 * E_M, DFF, cv_scr, it - 8192, DM / 32, lane, cvr);
                cv_pend = -1;
            }
        }
#undef SC_YOUT
#undef SC_LOAD2
#undef SC_STORE2
#undef SC_LOAD
#undef SC_STORE
    }
}

DI void gngate_phase(unsigned char* lds, const Ctx& a, const Op& d) {
    const int ia = d.idx;
    unsigned char* AR = a.ws + WS_AR;
    const bf16_t *R = (const bf16_t*)(AR + 384 * MiB), *Kb = (const bf16_t*)(AR + 448 * MiB), *Vb = (const bf16_t*)(ia == 0 ? a.ws + WS_VFIRST : AR + 512 * MiB);
    const bf16_t* AG = (const bf16_t*)(AR + 128 * MiB); const bf16_t* G = (const bf16_t*)(AR + 192 * MiB);
    const float* Y = (const float*)(AR + 256 * MiB);
    bf16_t* YG = (bf16_t*)(AR + 608 * MiB);
    LAS float* pl = (LAS float*)(LAS unsigned char*)lds;
    {
        const int t_ = TID_OF(a);
        const float *s0 = INP(a, 19) + ia * DM, *s1 = INP(a, 20) + ia * DM, *s2 = INP(a, 21) + ia * DM, *s3 = INP(a, 22) + ia * DM;
        for (int i = t_ * 4; i < DM; i += NTHREADS * 4) { *(LAS f32x4*)(pl + i) = *(const f32x4*)(s0 + i); *(LAS f32x4*)(pl + DM + i) = *(const f32x4*)(s1 + i);
            *(LAS f32x4*)(pl + 2 * DM + i) = *(const f32x4*)(s2 + i); *(LAS f32x4*)(pl + 3 * DM + i) = *(const f32x4*)(s3 + i); }
        __syncthreads();
    }
    const LAS float *k_a = pl, *r_k = pl + DM, *lw = pl + 2 * DM, *lb = pl + 3 * DM;
    const size_t total = (size_t)MTOK * DM / 8, stride = (size_t)a.G * NTHREADS;
#pragma unroll 2
    for (size_t it = (size_t)a.bid * NTHREADS + TID_OF(a); it < total; it += stride) {
        const size_t off = it * 8; const int col = (int)(off % DM);
        const f32x4 y0 = *(const f32x4*)(Y + off), y1 = *(const f32x4*)(Y + off + 4);
        const u32x4 ur = *(const u32x4*)(R + off), uk = *(const u32x4*)(Kb + off), uv = *(const u32x4*)(Vb + off), ua = *(const u32x4*)(AG + off), ug = *(const u32x4*)(G + off);
        float ys = ((y0[0] + y0[1]) + (y0[2] + y0[3])) + ((y1[0] + y1[1]) + (y1[2] + y1[3]));
        ys += dppf<0xB1>(ys); ys += dppf<0x4E>(ys); ys += dppf<0x141>(ys);
        const float mean = ys * (1.0f / 64.0f);
        const f32x4 d0 = y0 - mean, d1 = y1 - mean;
        float vs = ((d0[0] * d0[0] + d0[1] * d0[1]) + (d0[2] * d0[2] + d0[3] * d0[3])) + ((d1[0] * d1[0] + d1[1] * d1[1]) + (d1[2] * d1[2] + d1[3] * d1[3]));
        vs += dppf<0xB1>(vs); vs += dppf<0x4E>(vs); vs += dppf<0x141>(vs);
        const float rs = rsqrtf(vs * (1.0f / 64.0f) + 64e-5f);
        float rr[8], kk[8], vv[8], gg[8], dy[8];
        float bs = 0.f;
#pragma unroll
        for (int q = 0; q < 4; ++q) {
            rr[2 * q] = bflo(ur[q]); rr[2 * q + 1] = bfhi(ur[q]); vv[2 * q] = bflo(uv[q]); vv[2 * q + 1] = bfhi(uv[q]); gg[2 * q] = bflo(ug[q]); gg[2 * q + 1] = bfhi(ug[q]);
            const float a0 = bflo(ua[q]), a1 = bfhi(ua[q]);
            const float ka0 = k_a[col + 2 * q], ka1 = k_a[col + 2 * q + 1];
            kk[2 * q] = bflo(uk[q]) * (1.f + (a0 - 1.f) * ka0); kk[2 * q + 1] = bfhi(uk[q]) * (1.f + (a1 - 1.f) * ka1);
            bs += rr[2 * q] * kk[2 * q] * r_k[col + 2 * q] + rr[2 * q + 1] * kk[2 * q + 1] * r_k[col + 2 * q + 1];
        }
        bs += dppf<0xB1>(bs); bs += dppf<0x4E>(bs); bs += dppf<0x141>(bs);
#pragma unroll
        for (int q = 0; q < 4; ++q) { dy[q] = d0[q]; dy[4 + q] = d1[q]; }
        u32x4 w;
#pragma unroll
        for (int q = 0; q < 4; ++q) {
            const float o0 = (dy[2 * q] * rs * lw[col + 2 * q] + lb[col + 2 * q] + bs * vv[2 * q]) * gg[2 * q];
            const float o1 = (dy[2 * q + 1] * rs * lw[col + 2 * q + 1] + lb[col + 2 * q + 1] + bs * vv[2 * q + 1]) * gg[2 * q + 1];
            w[q] = pk2(o0, o1);
        }
        *(u32x4*)(YG + off) = w;
    }
}

DI void convgate_phase(const Ctx& a, const Op& d) {
    unsigned char* AR = a.ws + WS_AR;
    const bf16_t* BCH = (const bf16_t*)(AR + 64 * MiB); bf16_t* Z = (bf16_t*)(AR + 256 * MiB);
    const float* cw = INP(a, 29);
    constexpr int RUN = 16;
    const int total = (MTOK / RUN) * (DM / 8), stride = a.G * NTHREADS;
    for (int it = a.bid * NTHREADS + TID_OF(a); it < total; it += stride) {
        const int rn = it / (DM / 8), c0 = (it % (DM / 8)) * 8, t0 = rn * RUN;
        float w0[8], w1[8], w2[8], um2[8], um1[8];
#pragma unroll
        for (int e = 0; e < 8; ++e) { w0[e] = cw[c0 + e]; w1[e] = cw[DM + c0 + e]; w2[e] = cw[2 * DM + c0 + e]; um2[e] = 0.f; um1[e] = 0.f; }
        if ((t0 % SEQ) != 0) {
#pragma unroll
            for (int q = 0; q < 2; ++q) {
                const bf16_t* row = BCH + (size_t)(t0 - 2 + q) * 6144;
                const u32x4 c4 = *(const u32x4*)(row + DM + c0), h4 = *(const u32x4*)(row + 2 * DM + c0);
#pragma unroll
                for (int e = 0; e < 4; ++e) { const float u0 = bflo(c4[e]) * bflo(h4[e]), u1 = bfhi(c4[e]) * bfhi(h4[e]);
                    if (q == 0) { um2[2 * e] = u0; um2[2 * e + 1] = u1; } else { um1[2 * e] = u0; um1[2 * e + 1] = u1; } }
            }
        }
        for (int t = t0; t < t0 + RUN; ++t) {
            const bf16_t* row = BCH + (size_t)t * 6144;
            const u32x4 b4 = *(const u32x4*)(row + c0), c4 = *(const u32x4*)(row + DM + c0), h4 = *(const u32x4*)(row + 2 * DM + c0);
            u32x4 o;
#pragma unroll
            for (int e = 0; e < 4; ++e) {
                const float u0 = bflo(c4[e]) * bflo(h4[e]), u1 = bfhi(c4[e]) * bfhi(h4[e]);
                const float z0 = bflo(b4[e]) * (w0[2 * e] * um2[2 * e] + w1[2 * e] * um1[2 * e] + w2[2 * e] * u0);
                const float z1 = bfhi(b4[e]) * (w0[2 * e + 1] * um2[2 * e + 1] + w1[2 * e + 1] * um1[2 * e + 1] + w2[2 * e + 1] * u1);
                um2[2 * e] = um1[2 * e]; um2[2 * e + 1] = um1[2 * e + 1]; um1[2 * e] = u0; um1[2 * e + 1] = u1;
                o[e] = pk2(z0, z1);
            }
            *(u32x4*)(Z + (size_t)t * DM + c0) = o;
        }
    }
}

constexpr int AT_KP = 72, AT_VP = 264;
DI void attn_phase(unsigned char* lds, const Ctx& a, const Op& d, const int variant) {
    const int tid = TID_OF(a), lane = tid & 63, wave = tid >> 6;
    unsigned char* AR = a.ws + WS_AR;
    const bf16_t* QKV = (const bf16_t*)(AR + 64 * MiB); bf16_t* O = (bf16_t*)(AR + 144 * MiB);
    bf16_t* Ks = (bf16_t*)lds; bf16_t* Vt = (bf16_t*)(lds + 256 * AT_KP * 2);
    const int l32 = lane & 31, hh = lane >> 5;
    for (int unit = a.bid; unit < NB * 32 * 4; unit += a.G) {
        const int kvh = unit & 3, nb = (unit >> 2) & 31, b = unit >> 7;
        const size_t row0 = (size_t)b * SEQ + (size_t)nb * 128 - 128;
        bf16x8 qall[4][4];
        {
            const int qh_ = kvh * 8 + wave;
#pragma unroll
            for (int qc = 0; qc < 4; ++qc) {
                const size_t qrow_ = (size_t)b * SEQ + (size_t)nb * 128 + qc * 32 + l32;
#pragma unroll
                for (int ks = 0; ks < 4; ++ks) qall[qc][ks] = *(const bf16x8*)(QKV + qrow_ * 2560 + qh_ * 64 + ks * 16 + hh * 8);
            }
        }
        __syncthreads();
        if (!(variant & 2))
#pragma unroll
        for (int i = 0; i < 4; ++i) {
            const int chunk = tid + i * NTHREADS, key = chunk >> 3, dc = (chunk & 7) * 8;
            u32x4 kv = (u32x4){0u, 0u, 0u, 0u}, vv = (u32x4){0u, 0u, 0u, 0u};
            if (nb > 0 || key >= 128) { const bf16_t* rp = QKV + (row0 + key) * 2560 + 2048 + kvh * 64 + dc; kv = *(const u32x4*)rp; vv = *(const u32x4*)(rp + 256); }
            *(u32x4*)(Ks + key * AT_KP + dc) = kv;
#pragma unroll
            for (int e = 0; e < 4; ++e) { Vt[(dc + 2 * e) * AT_VP + key] = (bf16_t)(vv[e] & 0xffffu); Vt[(dc + 2 * e + 1) * AT_VP + key] = (bf16_t)(vv[e] >> 16); }
        }
        __syncthreads();
        const int qh = kvh * 8 + wave;
        const float sink = INP(a, 27)[qh];
        if (!(variant & 1))
#pragma unroll
        for (int qc = 0; qc < 4; ++qc) {
            const size_t qrow = (size_t)b * SEQ + (size_t)nb * 128 + qc * 32 + l32;
            bf16x8 qf[4];
#pragma unroll
            for (int ks = 0; ks < 4; ++ks) qf[ks] = qall[qc][ks];
            f32x16 s[5];
#pragma unroll
            for (int kb = 0; kb < 5; ++kb) {
#pragma unroll
                for (int i = 0; i < 16; ++i) s[kb][i] = 0.f;
                const int kbi = qc + kb;
#pragma unroll
                for (int ks = 0; ks < 4; ++ks) {
                    const bf16x8 kf = *(const bf16x8*)(Ks + (kbi * 32 + l32) * AT_KP + ks * 16 + hh * 8);
                    s[kb] = __builtin_amdgcn_mfma_f32_32x32x16_bf16(kf, qf[ks], s[kb], 0, 0, 0);
                }
            }
            const int qi = qc * 32 + l32;
            float mx = -INFINITY;
#pragma unroll
            for (int kb = 0; kb < 5; ++kb)
#pragma unroll
                for (int i = 0; i < 16; ++i) {
                    const int key = (qc + kb) * 32 + (i >> 2) * 8 + hh * 4 + (i & 3);
                    const int rel = 128 + qi - key;
                    const bool ok = (rel >= 0) && (rel < 128) && (nb > 0 || key >= 128);
                    s[kb][i] = ok ? s[kb][i] : -INFINITY;
                    mx = fmaxf(mx, s[kb][i]);
                }
            mx = fmaxf(mx, xor32(mx, lane));
            mx = fmaxf(mx, sink);
            float sum = 0.f;
#pragma unroll
            for (int kb = 0; kb < 5; ++kb)
#pragma unroll
                for (int i = 0; i < 16; ++i) { const float p = __expf(s[kb][i] - mx); s[kb][i] = p; sum += p; }
            sum += xor32(sum, lane);
            const float inv = 1.0f / (sum + __expf(sink - mx));
            f32x16 o[2];
#pragma unroll
            for (int db = 0; db < 2; ++db)
#pragma unroll
                for (int i = 0; i < 16; ++i) o[db][i] = 0.f;
#pragma unroll
            for (int kb = 0; kb < 5; ++kb)
#pragma unroll
                for (int st = 0; st < 2; ++st) {
                    u32x4 pw;
                    pw.x = pk2(s[kb][8 * st + 0], s[kb][8 * st + 1]); pw.y = pk2(s[kb][8 * st + 2], s[kb][8 * st + 3]);
                    pw.z = pk2(s[kb][8 * st + 4], s[kb][8 * st + 5]); pw.w = pk2(s[kb][8 * st + 6], s[kb][8 * st + 7]);
                    const bf16x8 pf = __builtin_bit_cast(bf16x8, pw);
                    const int key0 = (qc + kb) * 32 + (2 * st) * 8 + hh * 4;
#pragma unroll
                    for (int db = 0; db < 2; ++db) {
                        const bf16_t* vp = Vt + (db * 32 + l32) * AT_VP + key0;
                        const u32x2 v0 = *(const u32x2*)vp, v1 = *(const u32x2*)(vp + 8);
                        const u32x4 vw = (u32x4){v0.x, v0.y, v1.x, v1.y};
                        o[db] = __builtin_amdgcn_mfma_f32_32x32x16_bf16(__builtin_bit_cast(bf16x8, vw), pf, o[db], 0, 0, 0);
                    }
                }
            bf16_t* orow = O + qrow * DM + qh * 64;
#pragma unroll
            for (int db = 0; db < 2; ++db)
#pragma unroll
                for (int g4 = 0; g4 < 4; ++g4) {
                    u32x2 w; w.x = pk2(o[db][4 * g4] * inv, o[db][4 * g4 + 1] * inv); w.y = pk2(o[db][4 * g4 + 2] * inv, o[db][4 * g4 + 3] * inv);
                    *(u32x2*)(orow + db * 32 + g4 * 8 + hh * 4) = w;
                }
        }
    }
}

#define XB_TMO      128
#define XB_XCNT(j)  (256  + 64 * (j))
#define XB_XSUB(j)  (1280 + 64 * (j))
#define XB_XGEN(j)  (2304 + 64 * (j))
#define XB_TOP      3328
#define XB_TOPGEN   3392
#define XCD_BAR_WORDS 3456
#define XB_SPIN_CAP (1u << 18)

__device__ __forceinline__ unsigned xb_ld(unsigned* p)              { return __hip_atomic_load(p, __ATOMIC_RELAXED, __HIP_MEMORY_SCOPE_AGENT); }
__device__ __forceinline__ unsigned xb_add(unsigned* p, unsigned v) { return __hip_atomic_fetch_add(p, v, __ATOMIC_RELAXED, __HIP_MEMORY_SCOPE_AGENT); }
__device__ __forceinline__ unsigned xb_xcc_id() { return (unsigned)__builtin_amdgcn_s_getreg((3 << 11) | 20) & 0xFu; }
#define XB_SPIN(cond, bar) do { unsigned _sp = 0; while (cond) { __builtin_amdgcn_s_sleep(1); \
    if ((++_sp & 255u) == 0u) { if (xb_ld(&(bar)[XB_TMO])) break; if (_sp > XB_SPIN_CAP) { atomicAdd(&(bar)[XB_TMO], 1u); break; } } } } while (0)

struct XcdBarrier {
    unsigned* bar; unsigned x;
    volatile LAS unsigned* st;
};

__device__ __forceinline__ XcdBarrier xcd_barrier_post(unsigned* bar, volatile LAS unsigned* st) {
    XcdBarrier b; b.bar = bar; b.x = xb_xcc_id(); b.st = st;
    if (threadIdx.x == 0) (void)xb_add(&bar[XB_XCNT(b.x)], 1u);
    return b;
}
__device__ __forceinline__ void xcd_barrier_complete(unsigned* bar, unsigned x, unsigned& nloc, unsigned& nx) {
    const unsigned G = gridDim.x * gridDim.y * gridDim.z;
    unsigned sum, cnt, mine, sp = 0u;
    for (;;) {
        sum = 0u; cnt = 0u; mine = 0u;
#pragma unroll
        for (unsigned j = 0; j < 16; ++j) { const unsigned c = xb_ld(&bar[XB_XCNT(j)]); sum += c; cnt += (c > 0u) ? 1u : 0u; mine = (j == x) ? c : mine; }
        if (sum == G) break;
        __builtin_amdgcn_s_sleep(1);
        if ((++sp & 255u) == 0u) { if (xb_ld(&bar[XB_TMO])) break; if (sp > XB_SPIN_CAP) { atomicAdd(&bar[XB_TMO], 1u); break; } }
    }
    nloc = mine > 0u ? mine : 1u; nx = cnt > 0u ? cnt : 1u;
}

__device__ __forceinline__ void xcd_barrier(const XcdBarrier& b) {
    asm volatile("s_waitcnt vmcnt(0)" ::: "memory");
    __syncthreads();
    if (threadIdx.x == 0) {
        unsigned* bar = b.bar;
        __builtin_amdgcn_s_waitcnt(0);
        unsigned nloc = b.st[0], nx = b.st[1];
        if (nloc == 0u) { xcd_barrier_complete(bar, b.x, nloc, nx); b.st[0] = nloc; b.st[1] = nx; }
        const unsigned old = xb_add(&bar[XB_XSUB(b.x)], 1u);
        const unsigned gen = old / nloc;
        if (old + 1u == (gen + 1u) * nloc) {
            __builtin_amdgcn_fence(__ATOMIC_RELEASE, "agent");
            asm volatile("s_waitcnt vmcnt(0)" ::: "memory");
            const unsigned og = xb_add(&bar[XB_TOP], 1u);
            const unsigned tg = og / nx;
            if (og + 1u == (tg + 1u) * nx) xb_add(&bar[XB_TOPGEN], 1u);
            else XB_SPIN(xb_ld(&bar[XB_TOPGEN]) == tg, bar);
            __builtin_amdgcn_fence(__ATOMIC_ACQUIRE, "agent");
            xb_add(&bar[XB_XGEN(b.x)], 1u);
            asm volatile("s_waitcnt vmcnt(0)" ::: "memory");
        } else {
            XB_SPIN(xb_ld(&bar[XB_XGEN(b.x)]) == gen, bar);
            __builtin_amdgcn_fence(__ATOMIC_ACQUIRE, "agent");
            asm volatile("s_waitcnt vmcnt(0)" ::: "memory");
        }
    }
    __syncthreads();
}


constexpr size_t WS_BAR = 65536, BAR_BYTES = 16384;
constexpr int MISC_OFF = LDS_BYTES - 64;
__global__ void __launch_bounds__(NTHREADS, 2) fwd_megakernel(Args a) {
    extern __shared__ __attribute__((aligned(16))) unsigned char lds[];
    cg::grid_group grid = cg::this_grid();
    const int w0 = __builtin_amdgcn_readfirstlane(threadIdx.x >> 6);
    volatile LAS unsigned* bst = (volatile LAS unsigned*)((LAS unsigned char*)lds + MISC_OFF);
    if (threadIdx.x < 2) bst[threadIdx.x] = 0u;
    __syncthreads();
    XcdBarrier xbar = xcd_barrier_post((unsigned*)(a.ws + WS_BAR), bst);
    if (blockIdx.x == 0 && threadIdx.x == 0) {
        const float** tbl = (const float**)a.ws;
#pragma unroll
        for (int i = 0; i < 33; ++i) tbl[i] = a.in[i];
    }
    if (blockIdx.x == 0 && threadIdx.x == 64) {
        Op* tab = (Op*)(a.ws + WS_OPTAB);
        for (int op = 0; op < NOPS_TOTAL; ++op) { Op d; build_op(d, op, a); d.pad_[0] = 0; d.pad_[1] = 0; d.pad_[2] = 0; d.pad_[3] = 0; tab[op] = d; }
    }
    if (a.op_lo == 0) prologue_phase(lds, a, w0);
    if (a.op_hi < 0) grid.sync();
    xcd_barrier(xbar);
    for (int op = (a.op_lo == 0 ? 1 : a.op_lo); op < a.op_hi; ++op) {
        Ctx c;
        {
            unsigned long long po = (unsigned long long)a.out, pw = (unsigned long long)a.ws; int b_ = blockIdx.x, g_ = gridDim.x, w_ = w0;
            asm volatile("" : "+s"(po), "+s"(pw), "+s"(b_), "+s"(g_), "+s"(w_));
            const unsigned long long pol = (unsigned)__builtin_amdgcn_readfirstlane((int)(unsigned)po), poh = (unsigned)__builtin_amdgcn_readfirstlane((int)(unsigned)(po >> 32));
            const unsigned long long pwl = (unsigned)__builtin_amdgcn_readfirstlane((int)(unsigned)pw), pwh = (unsigned)__builtin_amdgcn_readfirstlane((int)(unsigned)(pw >> 32));
            c.out = (float*)(pol | (poh << 32)); c.ws = (unsigned char*)(pwl | (pwh << 32));
            c.bid = __builtin_amdgcn_readfirstlane(b_); c.G = __builtin_amdgcn_readfirstlane(g_); c.w0 = __builtin_amdgcn_readfirstlane(w_);
        }
        Op d;
        {
            const unsigned* p = (const unsigned*)(c.ws + WS_OPTAB) + (size_t)__builtin_amdgcn_readfirstlane(op) * 32;
            unsigned w[32];
#pragma unroll
            for (int i = 0; i < 32; ++i) w[i] = (unsigned)__builtin_amdgcn_readfirstlane((int)p[i]);
            __builtin_memcpy(&d, w, 128);
        }
#ifndef REP_MASK
#define REP_MASK 0
#endif
#ifndef SCAN_VARIANT
#define SCAN_VARIANT 0
#endif
#ifndef SYNC_REP
#define SYNC_REP 1
#endif
        const bool idem = (d.kind != K_GEMM) || (d.emode == pg8::EM_BF16 || d.emode == pg8::EM_DECAY) || (d.emode == pg8::EM_RESID && ((REP_MASK >> 9) & 1));
        const int reps = (((REP_MASK >> d.kind) & 1) && idem && d.kind != K_FINAL) ? 2 : 1;
        for (int rep = 0; rep < reps; ++rep) {
        if (rep) __syncthreads();
#ifndef NO_GEMM
        if (d.kind == K_GEMM) {
            pg8::Gemm g{d.A, d.Bt, d.lda, d.ldb, d.N, d.K};
            pg8::StaticOrder S; S.init(MTOK, d.N, c.G, (c.bid + c.G - d.shift) % c.G);
            pg8::Epi E{d.emode, d.act, d.out, d.ldc, d.bias, d.p1, d.qcols, rep};
            pg8::gemm_phase<pg8::StaticOrder>((LAS unsigned char*)lds, g, S, E, c.w0);
            if (d.idx == 7 || d.idx == 8) {
                const int first_idle = (c.G == 256) ? ((d.idx == 7) ? 128 : 192) : 0;
                if (c.bid >= first_idle) {
                    const int lane_ = lane_opaque(); float* scr = (float*)(lds + c.w0 * 16384);
                    const int gw = (c.bid - first_idle) * NWAVES + c.w0, NGW = (c.G - first_idle) * NWAVES;
                    if (d.idx == 7) {
                        convert_w(INP(c, 31) + (size_t)2 * DM * DFF, DM, DFF, (bf16_t*)(c.ws + WS_MLP), DM, DFF, scr, gw, NGW, lane_);
                        convert_w(INP(c, 32) + (size_t)2 * DM * DFF, DFF, DM, (bf16_t*)(c.ws + WS_MLP + 32 * MiB), DFF, DM, scr, gw, NGW, lane_);
                    } else {
                        convert_w(INP(c, 28), DM, 6144, (bf16_t*)(c.ws + WS_CONV), DM, 6144, scr, gw, NGW, lane_);
                        convert_w(INP(c, 30), DM, DM, (bf16_t*)(c.ws + WS_CONV + 24 * MiB), DM, DM, scr, gw, NGW, lane_);
                    }
                }
            }
        } else
#endif
#ifndef NO_MIX
        if (d.kind == K_MIX) mix_phase(lds, c, d); else
#endif
#ifndef NO_NORM
        if (d.kind == K_NORM) norm_phase(lds, c, d); else
#endif
#ifndef NO_SCAN
        if (d.kind == K_SCAN) scan_phase(lds, c, d, rep ? SCAN_VARIANT : 0); else
#endif
#ifndef NO_GN
        if (d.kind == K_GNGATE) gngate_phase(lds, c, d); else
#endif
#ifndef NO_ATTN
        if (d.kind == K_ATTN) attn_phase(lds, c, d, rep ? SCAN_VARIANT : 0); else
#endif
#ifndef NO_CONV
        if (d.kind == K_CONVGATE) convgate_phase(c, d); else
#endif
        final_phase(lds, c);
        }
        if (d.sync && op + 1 < a.op_hi) { for (int r = 0; r < SYNC_REP; ++r) xcd_barrier(xbar); } else __syncthreads();
    }
}

extern "C" void kernel_launch(void* const* d_in, const int* in_sizes, int n_in, void* d_out, int out_size, void* d_ws, size_t ws_size, hipStream_t stream) {
    static int grid_blocks = 0;
    if (!grid_blocks) {
        if (n_in != 33 || out_size != MTOK * DM || ws_size < WS_NEED) { fprintf(stderr, "kernel_launch: unexpected problem (n_in %d out %d ws %zu)\n", n_in, out_size, ws_size); grid_blocks = -1; return; }
        int dev = 0, cus = 0, per_cu = 0;
        (void)hipGetDevice(&dev);
        (void)hipDeviceGetAttribute(&cus, hipDeviceAttributeMultiprocessorCount, dev);
        (void)hipFuncSetAttribute((const void*)fwd_megakernel, hipFuncAttributeMaxDynamicSharedMemorySize, LDS_BYTES);
        (void)hipOccupancyMaxActiveBlocksPerMultiprocessor(&per_cu, (const void*)fwd_megakernel, NTHREADS, LDS_BYTES);
        if (per_cu < 1) per_cu = 1;
        grid_blocks = cus * per_cu;
        (void)hipGetLastError();
    }
    if (grid_blocks < 0) return;
    Args a{};
    for (int i = 0; i < 33; ++i) a.in[i] = (const float*)d_in[i];
    a.out = (float*)d_out; a.ws = (unsigned char*)d_ws; a.op_lo = 0; a.op_hi = NOPS_TOTAL;
    (void)hipMemsetAsync((char*)d_ws + WS_BAR, 0, BAR_BYTES, stream);
    void* args[] = {&a};
    hipError_t e = hipLaunchCooperativeKernel((const void*)fwd_megakernel, dim3(grid_blocks), dim3(NTHREADS), args, LDS_BYTES, stream);
    if (e != hipSuccess) fprintf(stderr, "cooperative launch failed: %s (grid %d)\n", hipGetErrorString(e), grid_blocks);
}
```
